# Optimizing an MI355X kernel written in HIP

```python
import math
import jax, jax.numpy as jnp
from jax import lax
import numpy as np

D_MODEL = 1024
BATCH = 4
SEQ = 8192
DEPTH = 4

N_A = DEPTH // 2
N_B = DEPTH - N_A
EXPAND = 2
A_WIDTH = EXPAND * D_MODEL
POOL_WINDOWS = (2, 4, 8, 16)
N_POOL_GROUPS = len(POOL_WINDOWS)
GROUP_WIDTH = A_WIDTH // N_POOL_GROUPS
HEAD_DIM = 64
N_HEADS = D_MODEL // HEAD_DIM
N_KV_HEADS = max(1, N_HEADS // 8)
GQA_GROUPS = N_HEADS // N_KV_HEADS
B_WIDTH = N_HEADS * HEAD_DIM
WINDOW = 128
BLOCK = 128
N_BUCKETS = 32
MAX_DISTANCE = 128
EPS = 1e-6
NEG_INF = -1e30

kernel_name = "yoco_pool_swa_sink_hybrid"


def rmsnorm(x, g):
    xf = x.astype(jnp.float32)
    y = xf * lax.rsqrt(jnp.mean(xf * xf, axis=-1, keepdims=True) + EPS)
    return y.astype(x.dtype) * g


def modulate(h, shift, scale):
    return h * (1 + scale[:, None, :]) + shift[:, None, :]


def t5_causal_buckets():
    i = np.arange(BLOCK)[:, None]
    j = np.arange(2 * BLOCK)[None, :]
    n = np.maximum(i + BLOCK - j, 0)
    max_exact = N_BUCKETS // 2
    large = max_exact + (np.log(np.maximum(n, 1) / max_exact) / math.log(MAX_DISTANCE / max_exact)
                         * (N_BUCKETS - max_exact)).astype(np.int32)
    large = np.minimum(large, N_BUCKETS - 1)
    return np.where(n < max_exact, n, large).astype(np.int32)


def band_mask(n_blocks):
    i = jnp.arange(BLOCK)[:, None]
    j = jnp.arange(2 * BLOCK)[None, :]
    rel = i + BLOCK - j
    band = (rel >= 0) & (rel < WINDOW)
    blk = jnp.arange(n_blocks)[:, None, None]
    return band[None] & ((blk > 0) | (j[None] >= BLOCK))


def causal_multiscale_pool(u):
    S = u.shape[1]
    uf = u.astype(jnp.float32)
    csp = jnp.pad(jnp.cumsum(uf, axis=1), ((0, 0), (1, 0), (0, 0)))
    t = jnp.arange(S)
    outs = []
    for g, w in enumerate(POOL_WINDOWS):
        c_g = csp[..., g * GROUP_WIDTH:(g + 1) * GROUP_WIDTH]
        upper = c_g[:, 1:]
        lower = jnp.pad(c_g, ((0, 0), (w, 0), (0, 0)))[:, 1:S + 1]
        count = jnp.minimum(t + 1, w).astype(jnp.float32)[None, :, None]
        outs.append((upper - lower) / count)
    return (jnp.concatenate(outs, axis=-1) - uf).astype(u.dtype)


def pool_mixer(h, w_in, w_group, scale, w_out):
    B, S, _ = h.shape
    u, z = jnp.split(h @ w_in, 2, axis=-1)
    p = causal_multiscale_pool(u).reshape(B, S, N_POOL_GROUPS, GROUP_WIDTH)
    y = jnp.einsum('bsgc,gcd->bsgd', p, w_group).reshape(B, S, A_WIDTH) * scale
    return (y * jax.nn.silu(z)) @ w_out


def shared_kv_blocks(x, c_act, kv_norm_g, kv_ada_w, kv_ada_b, w_kv):
    B, S, _ = x.shape
    nb = S // BLOCK
    shift, scale = jnp.split(c_act @ kv_ada_w + kv_ada_b, 2, axis=-1)
    hk = modulate(rmsnorm(x, kv_norm_g), shift, scale)
    kv = (hk @ w_kv).reshape(B, S, 2, N_KV_HEADS, HEAD_DIM)
    k, v = kv[:, :, 0], kv[:, :, 1]

    def to_band(t):
        prev = jnp.pad(t, ((0, 0), (BLOCK, 0), (0, 0), (0, 0)))[:, :S]
        prev = prev.reshape(B, nb, BLOCK, N_KV_HEADS, HEAD_DIM)
        cur = t.reshape(B, nb, BLOCK, N_KV_HEADS, HEAD_DIM)
        return jnp.concatenate([prev, cur], axis=2).transpose(1, 0, 2, 3, 4)

    return to_band(k), to_band(v)


def swa_sink_mixer(h, kb, vb, pos_bias, mask, w_in, sinks, w_out):
    B, S, _ = h.shape
    nb = S // BLOCK
    q, z = jnp.split(h @ w_in, 2, axis=-1)
    q = q * (HEAD_DIM ** -0.5)
    qb = q.reshape(B, nb, BLOCK, N_KV_HEADS, GQA_GROUPS, HEAD_DIM).transpose(1, 0, 2, 3, 4, 5)
    sink = sinks.astype(jnp.float32).reshape(N_KV_HEADS, GQA_GROUPS)[None, :, :, None, None]

    def block_fn(args):
        qn, kn, vn, mn = args
        s = jnp.einsum('bqhgd,bkhd->bhgqk', qn, kn).astype(jnp.float32) + pos_bias
        s = jnp.where(mn[None, None, None], s, NEG_INF)
        m = jnp.maximum(jnp.max(s, axis=-1, keepdims=True), sink)
        p = jnp.exp(s - m)
        p = p / (jnp.sum(p, axis=-1, keepdims=True) + jnp.exp(sink - m))
        return jnp.einsum('bhgqk,bkhd->bqhgd', p.astype(vn.dtype), vn)

    o = lax.map(block_fn, (qb, kb, vb, mask))
    o = o.transpose(1, 0, 2, 3, 4, 5).reshape(B, S, B_WIDTH)
    return (o * jax.nn.silu(z)) @ w_out


def setup_inputs(seed: int = 0) -> dict:
    key = jax.random.key(seed)
    ks = jax.random.split(key, 18)
    D, E, GW = D_MODEL, A_WIDTH, GROUP_WIDTH
    nrm = jax.random.normal
    f32 = jnp.float32
    return {
        "x": nrm(ks[0], (BATCH, SEQ, D), f32),
        "c": nrm(ks[1], (BATCH, D), f32),
        "norm_g": 1.0 + 0.05 * nrm(ks[2], (DEPTH, D), f32),
        "ada_w": 0.5 * D ** -0.5 * nrm(ks[3], (DEPTH, D, 3 * D), f32),
        "ada_b": 0.02 * nrm(ks[4], (DEPTH, 3 * D), f32),
        "a_w_in": D ** -0.5 * nrm(ks[5], (N_A, D, 2 * E), f32),
        "a_w_group": GW ** -0.5 * nrm(ks[6], (N_A, N_POOL_GROUPS, GW, GW), f32),
        "a_scale": 1.0 + 0.1 * nrm(ks[7], (N_A, E), f32),
        "a_w_out": E ** -0.5 * nrm(ks[8], (N_A, E, D), f32),
        "kv_norm_g": 1.0 + 0.05 * nrm(ks[9], (D,), f32),
        "kv_ada_w": 0.5 * D ** -0.5 * nrm(ks[10], (D, 2 * D), f32),
        "kv_ada_b": 0.02 * nrm(ks[11], (2 * D,), f32),
        "w_kv": D ** -0.5 * nrm(ks[12], (D, 2 * N_KV_HEADS * HEAD_DIM), f32),
        "b_w_in": D ** -0.5 * nrm(ks[13], (N_B, D, 2 * B_WIDTH), f32),
        "b_sinks": 0.5 * nrm(ks[14], (N_B, N_HEADS), f32),
        "b_w_out": B_WIDTH ** -0.5 * nrm(ks[15], (N_B, B_WIDTH, D), f32),
        "rel_bias": 0.5 * nrm(ks[16], (N_BUCKETS, N_HEADS), f32),
        "final_g": 1.0 + 0.05 * nrm(ks[17], (D,), f32),
    }


def reference(x, c, norm_g, ada_w, ada_b, a_w_in, a_w_group, a_scale, a_w_out,
              kv_norm_g, kv_ada_w, kv_ada_b, w_kv, b_w_in, b_sinks, b_w_out,
              rel_bias, final_g):
    S = x.shape[1]
    nb = S // BLOCK
    c_act = jax.nn.silu(c)
    buckets = t5_causal_buckets()
    pos_bias = rel_bias[buckets].astype(jnp.float32).transpose(2, 0, 1)
    pos_bias = pos_bias.reshape(N_KV_HEADS, GQA_GROUPS, BLOCK, 2 * BLOCK)[None]
    mask = band_mask(nb)

    kb = vb = None
    for l in range(DEPTH):
        shift, scale, gate = jnp.split(c_act @ ada_w[l] + ada_b[l], 3, axis=-1)
        if l < N_A:
            h = modulate(rmsnorm(x, norm_g[l]), shift, scale)
            y = pool_mixer(h, a_w_in[l], a_w_group[l], a_scale[l], a_w_out[l])
        else:
            if l == N_A:
                kb, vb = shared_kv_blocks(x, c_act, kv_norm_g, kv_ada_w, kv_ada_b, w_kv)
            j = l - N_A
            h = modulate(rmsnorm(x, norm_g[l]), shift, scale)
            y = swa_sink_mixer(h, kb, vb, pos_bias, mask, b_w_in[j], b_sinks[j], b_w_out[j])
        x = x + gate[:, None, :] * y
    return rmsnorm(x, final_g)
```

```cpp
#include <hip/hip_runtime.h>
#include <cstdint>
#include <cstdio>

typedef unsigned short bf16;
constexpr int D = 1024, NB = 4, S = 8192, T = NB * S, DEPTH = 4, NA = 2, E = 2048, GW = 512, HD = 64, NH = 16, NKV = 2, WIN = 128;
constexpr float EPS = 1e-6f;

__device__ const unsigned char BUCKET[128] = {0, 1, 2, 3, 4, 5, 6, 7, 8, 9, 10, 11, 12, 13, 14, 15, 16, 16, 16, 17, 17, 18, 18, 18, 19, 19, 19, 20, 20, 20, 20, 21, 21, 21, 21, 22, 22, 22, 22, 22, 23, 23, 23, 23, 23, 23, 24, 24, 24, 24, 24, 24, 25, 25, 25, 25, 25, 25, 25, 26, 26, 26, 26, 26, 26, 26, 26, 27, 27, 27, 27, 27, 27, 27, 27, 27, 27, 28, 28, 28, 28, 28, 28, 28, 28, 28, 28, 29, 29, 29, 29, 29, 29, 29, 29, 29, 29, 29, 29, 30, 30, 30, 30, 30, 30, 30, 30, 30, 30, 30, 30, 30, 30, 31, 31, 31, 31, 31, 31, 31, 31, 31, 31, 31, 31, 31, 31, 31};

__device__ __forceinline__ unsigned f2bf(float f) { unsigned u = __builtin_bit_cast(unsigned, f); return (u + 0x7fffu + ((u >> 16) & 1u)) >> 16; }
__device__ __forceinline__ float bf2f(unsigned short b) { return __builtin_bit_cast(float, (unsigned)b << 16); }
__device__ __forceinline__ float silu(float v) { return v / (1.f + expf(-v)); }

__global__ void __launch_bounds__(256) k_mod(const float* c, const float* ada_w, const float* ada_b, const float* kv_ada_w, const float* kv_ada_b, float* mod, float* kvmod) {
    const int gid = blockIdx.x * 256 + threadIdx.x;
    const float* W; const float* bias; float* out; int N, n;
    if (gid < DEPTH * 3 * D) { const int l = gid / (3 * D); n = gid % (3 * D); N = 3 * D; W = ada_w + (size_t)l * D * N; bias = ada_b + l * N; out = mod + (size_t)l * NB * N; }
    else { n = gid - DEPTH * 3 * D; if (n >= 2 * D) return; N = 2 * D; W = kv_ada_w; bias = kv_ada_b; out = kvmod; }
    float a0 = 0.f, a1 = 0.f, a2 = 0.f, a3 = 0.f;
    for (int k = 0; k < D; ++k) { const float w = W[(size_t)k * N + n]; a0 += silu(c[k]) * w; a1 += silu(c[D + k]) * w; a2 += silu(c[2 * D + k]) * w; a3 += silu(c[3 * D + k]) * w; }
    const float bb = bias[n];
    out[n] = a0 + bb; out[N + n] = a1 + bb; out[2 * N + n] = a2 + bb; out[3 * N + n] = a3 + bb;
}

__device__ __forceinline__ float wave_sum(float v) {
#pragma unroll
    for (int o = 1; o < 64; o <<= 1) v += __shfl_xor(v, o);
    return v;
}

__global__ void __launch_bounds__(256) k_norm(const float* x, const float* g, const float* mod, int modpitch, bf16* H) {
    const int row = blockIdx.x * 4 + (threadIdx.x >> 6), lane = threadIdx.x & 63, b = row / S;
    const float4* xr = (const float4*)(x + (size_t)row * D);
    float4 v[4]; float s = 0.f;
#pragma unroll
    for (int j = 0; j < 4; ++j) { v[j] = xr[lane + 64 * j]; s += v[j].x * v[j].x + v[j].y * v[j].y + v[j].z * v[j].z + v[j].w * v[j].w; }
    const float rstd = rsqrtf(wave_sum(s) * (1.f / D) + EPS);
    const float* sh = mod + (size_t)b * modpitch; const float* sc = sh + D;
#pragma unroll
    for (int j = 0; j < 4; ++j) {
        const int k = (lane + 64 * j) * 4;
        const float4 gg = *(const float4*)(g + k), s4 = *(const float4*)(sh + k), c4 = *(const float4*)(sc + k);
        const float o0 = v[j].x * rstd * gg.x * (1.f + c4.x) + s4.x, o1 = v[j].y * rstd * gg.y * (1.f + c4.y) + s4.y;
        const float o2 = v[j].z * rstd * gg.z * (1.f + c4.z) + s4.z, o3 = v[j].w * rstd * gg.w * (1.f + c4.w) + s4.w;
        uint2 w; w.x = f2bf(o0) | (f2bf(o1) << 16); w.y = f2bf(o2) | (f2bf(o3) << 16);
        *(uint2*)(H + (size_t)row * D + k) = w;
    }
}
__global__ void __launch_bounds__(256) k_final(const float* x, const float* g, float* out) {
    const int row = blockIdx.x * 4 + (threadIdx.x >> 6), lane = threadIdx.x & 63;
    const float4* xr = (const float4*)(x + (size_t)row * D);
    float4 v[4]; float s = 0.f;
#pragma unroll
    for (int j = 0; j < 4; ++j) { v[j] = xr[lane + 64 * j]; s += v[j].x * v[j].x + v[j].y * v[j].y + v[j].z * v[j].z + v[j].w * v[j].w; }
    const float rstd = rsqrtf(wave_sum(s) * (1.f / D) + EPS);
#pragma unroll
    for (int j = 0; j < 4; ++j) {
        const int k = (lane + 64 * j) * 4; const float4 gg = *(const float4*)(g + k);
        float4 o; o.x = v[j].x * rstd * gg.x; o.y = v[j].y * rstd * gg.y; o.z = v[j].z * rstd * gg.z; o.w = v[j].w * rstd * gg.w;
        *(float4*)(out + (size_t)row * D + k) = o;
    }
}

struct EpiStoreBf16 { bf16* C; int ldc; int pad; __device__ void operator()(int m, int n, float v) const { C[(size_t)m * ldc + n] = (bf16)f2bf(v); } };
struct EpiResidual { const float* Xin; float* Xout; const float* gate; int gpitch; int pad; __device__ void operator()(int m, int n, float v) const { const int b = m / S; Xout[(size_t)m * D + n] = Xin[(size_t)m * D + n] + gate[(size_t)b * gpitch + n] * v; } };
template <class Epi>
__global__ void __launch_bounds__(256) k_gemm(const bf16* A, int lda, const float* W, int ldw, int K, size_t strideA_z, size_t strideW_z, int coloff_z, Epi epi) {
    __shared__ float As[16][132]; __shared__ float Ws[16][132];
    A += (size_t)blockIdx.z * strideA_z; W += (size_t)blockIdx.z * strideW_z;
    const int tid = threadIdx.x, tx = tid & 15, ty = tid >> 4, m0 = blockIdx.y * 128, n0 = blockIdx.x * 128;
    float acc[8][8];
#pragma unroll
    for (int i = 0; i < 8; ++i)
#pragma unroll
        for (int j = 0; j < 8; ++j) acc[i][j] = 0.f;
    const int ar = tid >> 1, ak = (tid & 1) * 8, wk = tid >> 4, wn = (tid & 15) * 8;
    for (int k0 = 0; k0 < K; k0 += 16) {
        const uint4 av = *(const uint4*)(A + (size_t)(m0 + ar) * lda + k0 + ak);
        const float4 w0 = *(const float4*)(W + (size_t)(k0 + wk) * ldw + n0 + wn), w1 = *(const float4*)(W + (size_t)(k0 + wk) * ldw + n0 + wn + 4);
        __syncthreads();
        As[ak + 0][ar] = bf2f(av.x & 0xffff); As[ak + 1][ar] = bf2f(av.x >> 16); As[ak + 2][ar] = bf2f(av.y & 0xffff); As[ak + 3][ar] = bf2f(av.y >> 16);
        As[ak + 4][ar] = bf2f(av.z & 0xffff); As[ak + 5][ar] = bf2f(av.z >> 16); As[ak + 6][ar] = bf2f(av.w & 0xffff); As[ak + 7][ar] = bf2f(av.w >> 16);
        *(float4*)&Ws[wk][wn] = w0; *(float4*)&Ws[wk][wn + 4] = w1;
        __syncthreads();
#pragma unroll
        for (int k = 0; k < 16; ++k) {
            const float4 a0 = *(const float4*)&As[k][ty * 4], a1 = *(const float4*)&As[k][64 + ty * 4];
            const float4 b0 = *(const float4*)&Ws[k][tx * 4], b1 = *(const float4*)&Ws[k][64 + tx * 4];
            const float a[8] = {a0.x, a0.y, a0.z, a0.w, a1.x, a1.y, a1.z, a1.w}; const float b[8] = {b0.x, b0.y, b0.z, b0.w, b1.x, b1.y, b1.z, b1.w};
#pragma unroll
            for (int i = 0; i < 8; ++i)
#pragma unroll
                for (int j = 0; j < 8; ++j) acc[i][j] += a[i] * b[j];
        }
    }
    const int co = coloff_z * blockIdx.z;
#pragma unroll
    for (int i = 0; i < 8; ++i)
#pragma unroll
        for (int j = 0; j < 8; ++j) epi(m0 + (i >> 2) * 64 + ty * 4 + (i & 3), co + n0 + (j >> 2) * 64 + tx * 4 + (j & 3), acc[i][j]);
}

__global__ void __launch_bounds__(256) k_pool(const bf16* UZ, bf16* P) {
    const size_t gid = (size_t)blockIdx.x * 256 + threadIdx.x; const int j = (int)(gid % E), row = (int)(gid / E), t = row % S, w = 2 << (j / GW);
    const int cnt = (t + 1 < w) ? t + 1 : w; float s = 0.f;
    for (int i = 0; i < cnt; ++i) s += bf2f(UZ[(size_t)(row - i) * (2 * E) + j]);
    P[(size_t)row * E + j] = (bf16)f2bf(s / (float)cnt - bf2f(UZ[(size_t)row * (2 * E) + j]));
}
__global__ void __launch_bounds__(256) k_gate(const bf16* UZ, const float* scale, bf16* V) {
    const size_t gid = (size_t)blockIdx.x * 256 + threadIdx.x; const int j = (int)(gid % E); const size_t row = gid / E;
    V[row * E + j] = (bf16)f2bf(bf2f(UZ[row * 2 * E + j]) * scale[j] * silu(bf2f(UZ[row * 2 * E + E + j])));
}

__global__ void __launch_bounds__(256) k_attn(const bf16* QZ, const bf16* KV, const float* sinks, const float* rel_bias, bf16* AO) {
    const int gid = blockIdx.x * 256 + threadIdx.x, hq = gid & 15, row = gid >> 4, t = row % S, kvh = hq >> 3;
    float q[64], o[64];
#pragma unroll
    for (int d = 0; d < 64; ++d) { q[d] = bf2f(QZ[(size_t)row * 2 * D + hq * 64 + d]) * 0.125f; o[d] = 0.f; }
    float m = sinks[hq], l = 1.f;
    const int nk = (t + 1 < WIN) ? t + 1 : WIN;
    for (int i = 0; i < nk; ++i) {
        const bf16* kr = KV + (size_t)(row - i) * 256 + kvh * 64; const bf16* vr = kr + 128;
        float s = 0.f;
#pragma unroll
        for (int d = 0; d < 64; ++d) s += q[d] * bf2f(kr[d]);
        s += rel_bias[BUCKET[i] * NH + hq];
        const float mn = fmaxf(m, s), corr = expf(m - mn), p = expf(s - mn);
        l = l * corr + p; m = mn;
#pragma unroll
        for (int d = 0; d < 64; ++d) o[d] = o[d] * corr + p * bf2f(vr[d]);
    }
    const float il = 1.f / l;
#pragma unroll
    for (int d = 0; d < 64; ++d) { const float z = bf2f(QZ[(size_t)row * 2 * D + D + hq * 64 + d]); AO[(size_t)row * D + hq * 64 + d] = (bf16)f2bf(o[d] * il * silu(z)); }
}

extern "C" void kernel_launch(void* const* d_in, const int* in_sizes, int n_in, void* d_out, int out_size, void* d_ws, size_t ws_size, hipStream_t stream) {
    const float* x = (const float*)d_in[0]; const float* c = (const float*)d_in[1]; const float* norm_g = (const float*)d_in[2]; const float* ada_w = (const float*)d_in[3];
    const float* ada_b = (const float*)d_in[4]; const float* a_w_in = (const float*)d_in[5]; const float* a_w_group = (const float*)d_in[6]; const float* a_scale = (const float*)d_in[7];
    const float* a_w_out = (const float*)d_in[8]; const float* kv_norm_g = (const float*)d_in[9]; const float* kv_ada_w = (const float*)d_in[10]; const float* kv_ada_b = (const float*)d_in[11];
    const float* w_kv = (const float*)d_in[12]; const float* b_w_in = (const float*)d_in[13]; const float* b_sinks = (const float*)d_in[14]; const float* b_w_out = (const float*)d_in[15];
    const float* rel_bias = (const float*)d_in[16]; const float* final_g = (const float*)d_in[17];
    float* X = (float*)d_out; unsigned char* ws = (unsigned char*)d_ws;
    constexpr size_t MiB = 1u << 20;
    float* mod = (float*)(ws); float* kvmod = (float*)(ws + 1 * MiB);
    bf16* H = (bf16*)(ws + 2 * MiB);
    bf16* UZ = (bf16*)(ws + 66 * MiB);
    bf16* PV = (bf16*)(ws + 322 * MiB);
    if (ws_size < 450 * MiB) { fprintf(stderr, "ws too small: %zu\n", ws_size); return; }
    k_mod<<<(DEPTH * 3 * D + 2 * D + 255) / 256, 256, 0, stream>>>(c, ada_w, ada_b, kv_ada_w, kv_ada_b, mod, kvmod);
    const float* Xin = x;
    for (int l = 0; l < DEPTH; ++l) {
        const float* ml = mod + (size_t)l * NB * 3 * D;
        k_norm<<<T / 4, 256, 0, stream>>>(Xin, norm_g + l * D, ml, 3 * D, H);
        if (l < NA) {
            k_gemm<EpiStoreBf16><<<dim3(2 * E / 128, T / 128, 1), 256, 0, stream>>>(H, D, a_w_in + (size_t)l * D * 2 * E, 2 * E, D, 0, 0, 0, EpiStoreBf16{UZ, 2 * E, 0});
            k_pool<<<(unsigned)((size_t)T * E / 256), 256, 0, stream>>>(UZ, PV);
            k_gemm<EpiStoreBf16><<<dim3(GW / 128, T / 128, 4), 256, 0, stream>>>(PV, E, a_w_group + (size_t)l * 4 * GW * GW, GW, GW, GW, (size_t)GW * GW, GW, EpiStoreBf16{UZ, 2 * E, 0});
            k_gate<<<(unsigned)((size_t)T * E / 256), 256, 0, stream>>>(UZ, a_scale + l * E, PV);
            k_gemm<EpiResidual><<<dim3(D / 128, T / 128, 1), 256, 0, stream>>>(PV, E, a_w_out + (size_t)l * E * D, D, E, 0, 0, 0, EpiResidual{Xin, X, ml + 2 * D, 3 * D, 0});
        } else {
            const int j = l - NA;
            bf16* QZ = UZ; bf16* HK = (bf16*)(ws + (66 + 128) * MiB); bf16* KVb = (bf16*)(ws + (66 + 192) * MiB);
            if (l == NA) {
                k_norm<<<T / 4, 256, 0, stream>>>(Xin, kv_norm_g, kvmod, 2 * D, HK);
                k_gemm<EpiStoreBf16><<<dim3(256 / 128, T / 128, 1), 256, 0, stream>>>(HK, D, w_kv, 256, D, 0, 0, 0, EpiStoreBf16{KVb, 256, 0});
            }
            k_gemm<EpiStoreBf16><<<dim3(2 * D / 128, T / 128, 1), 256, 0, stream>>>(H, D, b_w_in + (size_t)j * D * 2 * D, 2 * D, D, 0, 0, 0, EpiStoreBf16{QZ, 2 * D, 0});
            k_attn<<<T * NH / 256, 256, 0, stream>>>(QZ, KVb, b_sinks + j * NH, rel_bias, PV);
            k_gemm<EpiResidual><<<dim3(D / 128, T / 128, 1), 256, 0, stream>>>(PV, D, b_w_out + (size_t)j * D * D, D, D, 0, 0, 0, EpiResidual{Xin, X, ml + 2 * D, 3 * D, 0});
        }
        Xin = X;
    }
    k_final<<<T / 4, 256, 0, stream>>>(X, final_g, X);
}
```

```cpp
#include <hip/hip_runtime.h>
#include <cstdint>
#include <cstdio>

typedef unsigned short bf16;
constexpr int D = 1024, NB = 4, S = 8192, T = NB * S, DEPTH = 4, NA = 2, E = 2048, GW = 512, HD = 64, NH = 16, NKV = 2, WIN = 128;
constexpr float EPS = 1e-6f;

__device__ const unsigned char BUCKET[128] = {0, 1, 2, 3, 4, 5, 6, 7, 8, 9, 10, 11, 12, 13, 14, 15, 16, 16, 16, 17, 17, 18, 18, 18, 19, 19, 19, 20, 20, 20, 20, 21, 21, 21, 21, 22, 22, 22, 22, 22, 23, 23, 23, 23, 23, 23, 24, 24, 24, 24, 24, 24, 25, 25, 25, 25, 25, 25, 25, 26, 26, 26, 26, 26, 26, 26, 26, 27, 27, 27, 27, 27, 27, 27, 27, 27, 27, 28, 28, 28, 28, 28, 28, 28, 28, 28, 28, 29, 29, 29, 29, 29, 29, 29, 29, 29, 29, 29, 29, 30, 30, 30, 30, 30, 30, 30, 30, 30, 30, 30, 30, 30, 30, 31, 31, 31, 31, 31, 31, 31, 31, 31, 31, 31, 31, 31, 31, 31};

__device__ __forceinline__ unsigned f2bf(float f) { unsigned u = __builtin_bit_cast(unsigned, f); return (u + 0x7fffu + ((u >> 16) & 1u)) >> 16; }
__device__ __forceinline__ float bf2f(unsigned short b) { return __builtin_bit_cast(float, (unsigned)b << 16); }
__device__ __forceinline__ float silu(float v) { return v / (1.f + expf(-v)); }

__device__ __forceinline__ float wave_sum(float v) {
#pragma unroll
    for (int o = 1; o < 64; o <<= 1) v += __shfl_xor(v, o);
    return v;
}
namespace pg8 {
#define PG8_LAS __attribute__((address_space(3)))
typedef unsigned short bf16_t;
typedef short bf16x8 __attribute__((ext_vector_type(8)));
typedef float f32x4 __attribute__((ext_vector_type(4)));
typedef float f32x2 __attribute__((ext_vector_type(2)));
typedef unsigned u32x4 __attribute__((ext_vector_type(4)));
typedef unsigned u32x2 __attribute__((ext_vector_type(2)));
constexpr int BM = 256, BK = 64, HALF = 128, HTB = HALF * BK * 2  , STAGE_BYTES = 8 * HTB, NXCD = 8, WGM = 8;

__host__ __device__ __forceinline__ int lds_byte(int r, int c) { const int st = (r >> 4) * 2 + (c >> 5), rr = r & 15, cc = c & 31, ob = rr * 64 + cc * 2; return st * 1024 + (ob ^ (((ob >> 9) & 1) << 5)); }
__host__ __device__ __forceinline__ void stage_rc(int b, int& R, int& C) { const int st = b / 1024, sb = b % 1024, swz = sb ^ (((sb >> 9) & 1) << 5); R = (st >> 1) * 16 + swz / 64; C = (st & 1) * 32 + (swz % 64) / 2; }
__host__ __device__ __forceinline__ int perm32(int rho) { const int n = rho >> 4, i = rho & 15; return 8 * (i >> 2) + 4 * n + (i & 3); }

struct Unit { int pm, pn, gi; };

__device__ __forceinline__ unsigned cvt_pk_bf16(float lo, float hi) { unsigned r; asm volatile("v_cvt_pk_bf16_f32 %0, %1, %2" : "=v"(r) : "v"(lo), "v"(hi)); return r; }

template <int K, int LDA, int LDB, class Epi, class Sched, bool ALIGN_EPI = true, bool SP2 = true>
__device__ __forceinline__ void gemm_phase(PG8_LAS unsigned char* lds, PG8_LAS unsigned char* ldsx, const Sched& S, const Epi& E) {
    int tid_ = threadIdx.x; asm volatile("" : "+v"(tid_));
    const int tid = tid_, wid = __builtin_amdgcn_readfirstlane(tid >> 6), lane = tid & 63, wr = wid >> 2, wc = wid & 3, fr = lane & 15, fq = lane >> 4;
    constexpr int nt = K / BK;
    unsigned voffA[2], voffB[2];
#pragma unroll
    for (int i = 0; i < 2; ++i) { int R, C; stage_rc(tid * 16 + i * 8192, R, C); const int Rb = Epi::PERM ? ((R & ~31) + perm32(R & 31)) : R;
        voffA[i] = (unsigned)(R * LDA + C) * 2u; voffB[i] = (unsigned)(Rb * LDB + C) * 2u; }
    constexpr size_t kstep = (size_t)(BK * 2);
    constexpr size_t hstepA = (size_t)HALF * LDA * 2, hstepB = (size_t)HALF * LDB * 2;
    const unsigned ldsw = (unsigned)wid * 1024u;
    const int aoff = lds_byte(wr * 64 + fr, fq * 8), boff = lds_byte(wc * 32 + fr, fq * 8);
#define PG8_SA(b, h) (((b) * 2 + (h)) * HTB)
#define PG8_SB(b, h) ((4 + (b) * 2 + (h)) * HTB)
#define PG8_STAGE(bufoff, gbase, voff) do { _Pragma("unroll") for (int _i = 0; _i < 2; ++_i) \
        __builtin_amdgcn_global_load_lds((const unsigned*)((const char*)(gbase) + (voff)[_i]), (PG8_LAS unsigned*)(lds + (bufoff) + ldsw + _i * 8192), 16, 0, 0); } while (0)
#define PG8_LDA(dst, b, h) do { _Pragma("unroll") for (int m = 0; m < 4; ++m) _Pragma("unroll") for (int k = 0; k < 2; ++k) dst[m][k] = *(const PG8_LAS bf16x8*)(lds + PG8_SA(b, h) + aoff + m * 2048 + k * 1024); } while (0)
#define PG8_LDB(dst, b, h) do { _Pragma("unroll") for (int n = 0; n < 2; ++n) _Pragma("unroll") for (int k = 0; k < 2; ++k) dst[n][k] = *(const PG8_LAS bf16x8*)(lds + PG8_SB(b, h) + boff + n * 2048 + k * 1024); } while (0)
#define PG8_MMA(ai, bj, At, Bt) do { __builtin_amdgcn_s_setprio(1); _Pragma("unroll") for (int m = 0; m < 4; ++m) _Pragma("unroll") for (int n = 0; n < 2; ++n) _Pragma("unroll") for (int k = 0; k < 2; ++k) \
        acc[ai][bj][m][n] = __builtin_amdgcn_mfma_f32_16x16x32_bf16(Bt[n][k], At[m][k], acc[ai][bj][m][n], 0, 0, 0); __builtin_amdgcn_s_setprio(0); } while (0)
#define PG8_WAIT_V(n) asm volatile("s_waitcnt vmcnt(" #n ")" ::: "memory")
#define PG8_WAIT_L(n) asm volatile("s_waitcnt lgkmcnt(" #n ")" ::: "memory")
#define PG8_BAR __builtin_amdgcn_s_barrier()
#define PG8_SCHED __builtin_amdgcn_sched_barrier(0)
    Unit cur, nxt; int ui = 0;
    if (!S.next(0, cur)) return;
    f32x4 acc[2][2][4][2];
#pragma unroll
    for (int a = 0; a < 2; ++a)
#pragma unroll
        for (int b = 0; b < 2; ++b)
#pragma unroll
            for (int m = 0; m < 4; ++m)
#pragma unroll
                for (int n = 0; n < 2; ++n) acc[a][b][m][n] = (f32x4){0.f, 0.f, 0.f, 0.f};
    bf16x8 At[4][2], B0[2][2], B1[2][2];
    const char* cA; const char* cB; S.ab(cur, cA, cB);
    if constexpr (SP2) {
        PG8_STAGE(PG8_SB(0, 0), cB, voffB); PG8_STAGE(PG8_SB(0, 1), cB + hstepB, voffB); PG8_STAGE(PG8_SA(0, 0), cA, voffA); PG8_STAGE(PG8_SA(0, 1), cA + hstepA, voffA);
        if (wr == 1) PG8_BAR;
        PG8_WAIT_V(2); PG8_BAR;
        PG8_STAGE(PG8_SB(1, 0), cB + kstep, voffB); PG8_STAGE(PG8_SA(1, 0), cA + kstep, voffA); PG8_STAGE(PG8_SB(1, 1), cB + hstepB + kstep, voffB);
        PG8_WAIT_V(6); PG8_BAR;
    } else {
        PG8_STAGE(PG8_SB(0, 0), cB, voffB); PG8_STAGE(PG8_SA(0, 0), cA, voffA); PG8_STAGE(PG8_SB(0, 1), cB + hstepB, voffB); PG8_STAGE(PG8_SA(0, 1), cA + hstepA, voffA);
        if (wr == 1) PG8_BAR;
        PG8_WAIT_V(4); PG8_BAR;
        PG8_STAGE(PG8_SB(1, 0), cB + kstep, voffB); PG8_STAGE(PG8_SA(1, 0), cA + kstep, voffA); PG8_STAGE(PG8_SB(1, 1), cB + hstepB + kstep, voffB);
        PG8_WAIT_V(6); PG8_BAR;
    }
    for (;;) {
        const bool has_next = S.next(ui + 1, nxt);
        const char* nA = cA; const char* nB = cB; if (has_next) S.ab(nxt, nA, nB);
        for (int t = 0; t < nt; t += 2) {
            const bool last = (t == nt - 2);
            const char* a1 = cA + (size_t)(t + 1) * kstep;
            const char* a2 = last ? nA : cA + (size_t)(t + 2) * kstep; const char* b2 = last ? nB : cB + (size_t)(t + 2) * kstep;
            const char* a3 = a2 + kstep; const char* b3 = b2 + kstep;
            if constexpr (SP2) {
            PG8_LDB(B0, 0, 0); PG8_LDB(B1, 0, 1); PG8_SCHED; PG8_LDA(At, 0, 0); PG8_STAGE(PG8_SA(1, 1), a1 + hstepA, voffA);
            PG8_WAIT_V(8); PG8_WAIT_L(0); PG8_BAR; PG8_MMA(0, 0, At, B0); PG8_MMA(0, 1, At, B1); PG8_BAR; PG8_SCHED;
            PG8_LDA(At, 0, 1); PG8_STAGE(PG8_SB(0, 0), b2, voffB); PG8_STAGE(PG8_SB(0, 1), b2 + hstepB, voffB); PG8_STAGE(PG8_SA(0, 0), a2, voffA);
            PG8_WAIT_V(8); PG8_WAIT_L(0); PG8_BAR; PG8_MMA(1, 0, At, B0); PG8_MMA(1, 1, At, B1); PG8_BAR; PG8_SCHED;
            PG8_LDB(B0, 1, 0); PG8_LDB(B1, 1, 1); PG8_SCHED; PG8_LDA(At, 1, 0); PG8_STAGE(PG8_SA(0, 1), a2 + hstepA, voffA);
            PG8_WAIT_V(8); PG8_WAIT_L(0); PG8_BAR; PG8_MMA(0, 0, At, B0); PG8_MMA(0, 1, At, B1); PG8_BAR; PG8_SCHED;
            PG8_LDA(At, 1, 1); PG8_STAGE(PG8_SB(1, 0), b3, voffB); PG8_STAGE(PG8_SB(1, 1), b3 + hstepB, voffB); PG8_STAGE(PG8_SA(1, 0), a3, voffA);
            PG8_WAIT_V(8); PG8_WAIT_L(0); PG8_BAR; PG8_MMA(1, 0, At, B0); PG8_MMA(1, 1, At, B1); PG8_BAR; PG8_SCHED;
            } else {
            PG8_LDB(B0, 0, 0); PG8_SCHED; PG8_LDA(At, 0, 0); PG8_STAGE(PG8_SA(1, 1), a1 + hstepA, voffA);
            PG8_WAIT_L(8); PG8_BAR; PG8_WAIT_L(0); PG8_MMA(0, 0, At, B0); PG8_BAR; PG8_SCHED;
            PG8_LDB(B1, 0, 1); PG8_STAGE(PG8_SB(0, 0), b2, voffB);
            PG8_BAR; PG8_WAIT_L(0); PG8_MMA(0, 1, At, B1); PG8_BAR;
            PG8_LDA(At, 0, 1); PG8_STAGE(PG8_SA(0, 0), a2, voffA);
            PG8_BAR; PG8_WAIT_L(0); PG8_MMA(1, 0, At, B0); PG8_BAR; PG8_SCHED;
            PG8_STAGE(PG8_SB(0, 1), b2 + hstepB, voffB);
            PG8_WAIT_V(6); PG8_BAR; PG8_MMA(1, 1, At, B1); PG8_BAR;
            PG8_LDB(B0, 1, 0); PG8_SCHED; PG8_LDA(At, 1, 0); PG8_STAGE(PG8_SA(0, 1), a2 + hstepA, voffA);
            PG8_WAIT_L(8); PG8_BAR; PG8_WAIT_L(0); PG8_MMA(0, 0, At, B0); PG8_BAR; PG8_SCHED;
            PG8_LDB(B1, 1, 1); PG8_STAGE(PG8_SB(1, 0), b3, voffB);
            PG8_BAR; PG8_WAIT_L(0); PG8_MMA(0, 1, At, B1); PG8_BAR;
            PG8_LDA(At, 1, 1); PG8_STAGE(PG8_SA(1, 0), a3, voffA);
            PG8_BAR; PG8_WAIT_L(0); PG8_MMA(1, 0, At, B0); PG8_BAR; PG8_SCHED;
            PG8_STAGE(PG8_SB(1, 1), b3 + hstepB, voffB);
            PG8_WAIT_V(6); PG8_BAR; PG8_MMA(1, 1, At, B1); PG8_BAR;
            }
        }
        if constexpr (ALIGN_EPI) { if (wr == 0) PG8_BAR; }
        { int fr_e = fr, fq_e = fq, lane_e = lane, wr_e = wr, wc_e = wc;
          asm volatile("" : "+v"(fr_e), "+v"(fq_e), "+v"(lane_e)); asm volatile("" : "+s"(wr_e), "+s"(wc_e));
          E(acc, cur, ui, wr_e, wc_e, fr_e, fq_e, lane_e, ldsx); }
        if (!has_next) break;
#pragma unroll
        for (int a = 0; a < 2; ++a)
#pragma unroll
            for (int b = 0; b < 2; ++b)
#pragma unroll
                for (int m = 0; m < 4; ++m)
#pragma unroll
                    for (int n = 0; n < 2; ++n) acc[a][b][m][n] = (f32x4){0.f, 0.f, 0.f, 0.f};
        cur = nxt; cA = nA; cB = nB; ++ui;
        if constexpr (ALIGN_EPI) { if (wr == 1) PG8_BAR; }
    }
    PG8_WAIT_V(0);
    if constexpr (!ALIGN_EPI) { if (wr == 0) PG8_BAR; }
    PG8_BAR;
#undef PG8_SA
#undef PG8_SB
#undef PG8_STAGE
#undef PG8_LDA
#undef PG8_LDB
#undef PG8_MMA
#undef PG8_WAIT_V
#undef PG8_WAIT_L
#undef PG8_BAR
#undef PG8_SCHED
}
}
#define GAS __attribute__((address_space(1)))
#define LAS __attribute__((address_space(3)))
typedef unsigned v4u __attribute__((ext_vector_type(4)));
typedef float f32x4 __attribute__((ext_vector_type(4)));
typedef GAS unsigned gu32;
#define RLX_AGENT __ATOMIC_RELAXED, __HIP_MEMORY_SCOPE_AGENT
#define LDS_WAIT() asm volatile("s_waitcnt lgkmcnt(0)" ::: "memory")
#define VM_WAIT() asm volatile("s_waitcnt vmcnt(0)" ::: "memory")
__device__ __forceinline__ unsigned pk2(float lo, float hi) { return f2bf(lo) | (f2bf(hi) << 16); }
__device__ __forceinline__ float fsilu(float v) { return v * __builtin_amdgcn_rcpf(1.f + __builtin_amdgcn_exp2f(-1.4426950408889634f * v)); }

__device__ __forceinline__ int opq(int v) { asm volatile("" : "+s"(v)); return v; }
template <class Tp> __device__ __forceinline__ Tp* opqp(Tp* p) { unsigned long long v = (unsigned long long)p; unsigned lo = (unsigned)v, hi = (unsigned)(v >> 32); asm volatile("" : "+s"(lo), "+s"(hi)); return (Tp*)(((unsigned long long)hi << 32) | lo); }
#define XB_TMO      128
#define XB_XCNT(j)  (256  + 64 * (j))
#define XB_XSUB(j)  (1280 + 64 * (j))
#define XB_XGEN(j)  (2304 + 64 * (j))
#define XB_TOP      3328
#define XB_TOPGEN   3392
#define XCD_BAR_WORDS 3456
#define XB_SPIN_CAP (1u << 18)
__device__ __forceinline__ unsigned xb_ld(unsigned* p)              { return __hip_atomic_load(p, __ATOMIC_RELAXED, __HIP_MEMORY_SCOPE_AGENT); }
__device__ __forceinline__ unsigned xb_add(unsigned* p, unsigned v) { return __hip_atomic_fetch_add(p, v, __ATOMIC_RELAXED, __HIP_MEMORY_SCOPE_AGENT); }
__device__ __forceinline__ unsigned xb_xcc_id() { return (unsigned)__builtin_amdgcn_s_getreg((3 << 11) | 20) & 0xFu; }
#define XB_SPIN(cond, bar) do { unsigned _sp = 0; while (cond) { __builtin_amdgcn_s_sleep(1); \
    if ((++_sp & 255u) == 0u) { if (xb_ld(&(bar)[XB_TMO])) break; if (_sp > XB_SPIN_CAP) { atomicAdd(&(bar)[XB_TMO], 1u); break; } } } } while (0)
struct XcdBarrier { unsigned* bar; unsigned x; volatile LAS unsigned* st; };
__device__ __forceinline__ XcdBarrier xcd_barrier_post(unsigned* bar, volatile LAS unsigned* st) {
    XcdBarrier b; b.bar = bar; b.x = xb_xcc_id(); b.st = st;
    if (threadIdx.x == 0) (void)xb_add(&bar[XB_XCNT(b.x)], 1u);
    return b;
}
__device__ __forceinline__ void xcd_barrier_complete(unsigned* bar, unsigned x, unsigned& nloc, unsigned& nx) {
    const unsigned G = gridDim.x * gridDim.y * gridDim.z;
    unsigned sum, cnt, mine, sp = 0u;
    for (;;) {
        sum = 0u; cnt = 0u;
#pragma unroll 1
        for (unsigned j = 0; j < 16; ++j) { const unsigned c = xb_ld(&bar[XB_XCNT(j)]); sum += c; cnt += (c > 0u) ? 1u : 0u; }
        mine = xb_ld(&bar[XB_XCNT(x)]);
        if (sum == G) break;
        __builtin_amdgcn_s_sleep(1);
        if ((++sp & 255u) == 0u) { if (xb_ld(&bar[XB_TMO])) break; if (sp > XB_SPIN_CAP) { atomicAdd(&bar[XB_TMO], 1u); break; } }
    }
    nloc = mine > 0u ? mine : 1u; nx = cnt > 0u ? cnt : 1u;
}
__device__ __forceinline__ void xcd_barrier(const XcdBarrier& b) {
    asm volatile("s_waitcnt vmcnt(0)" ::: "memory");
    __syncthreads();
    if (threadIdx.x == 0) {
        unsigned* bar = opqp(b.bar);
        __builtin_amdgcn_s_waitcnt(0);
        unsigned nloc = b.st[0], nx = b.st[1];
        if (nloc == 0u) { xcd_barrier_complete(bar, b.x, nloc, nx); b.st[0] = nloc; b.st[1] = nx; }
        const unsigned old = xb_add(&bar[XB_XSUB(b.x)], 1u);
        const unsigned gen = old / nloc;
        if (old + 1u == (gen + 1u) * nloc) {
            __builtin_amdgcn_fence(__ATOMIC_RELEASE, "agent");
            asm volatile("s_waitcnt vmcnt(0)" ::: "memory");
            const unsigned og = xb_add(&bar[XB_TOP], 1u);
            const unsigned tg = og / nx;
            if (og + 1u == (tg + 1u) * nx) xb_add(&bar[XB_TOPGEN], 1u);
            else XB_SPIN(xb_ld(&bar[XB_TOPGEN]) == tg, bar);
            __builtin_amdgcn_fence(__ATOMIC_ACQUIRE, "agent");
            xb_add(&bar[XB_XGEN(b.x)], 1u);
            asm volatile("s_waitcnt vmcnt(0)" ::: "memory");
        } else {
            XB_SPIN(xb_ld(&bar[XB_XGEN(b.x)]) == gen, bar);
            __builtin_amdgcn_fence(__ATOMIC_ACQUIRE, "agent");
            asm volatile("s_waitcnt vmcnt(0)" ::: "memory");
        }
    }
    __syncthreads();
}

constexpr size_t MiB = 1u << 20;
constexpr size_t WS_CTL = 0, CTL_ZERO_BYTES = 1 * MiB;
constexpr size_t WS_MOD = 1 * MiB;
constexpr size_t WS_W1A = 2 * MiB;
constexpr size_t WS_W2A = 18 * MiB;
constexpr size_t WS_WKV = 26 * MiB;
constexpr size_t WS_W1B = 27 * MiB;
constexpr size_t WS_W2B = 35 * MiB;
constexpr size_t WS_WUB = 39 * MiB;
constexpr size_t WS_WGT = 47 * MiB;
constexpr size_t WS_K = 51 * MiB;
constexpr size_t WS_VT = 59 * MiB;
constexpr size_t WS_TAIL = 67 * MiB, WS_HEADY = 83 * MiB, WS_HEADZ = 99 * MiB;
constexpr size_t WS_H = 116 * MiB;
constexpr size_t WS_V = 180 * MiB;
constexpr size_t WS_HK = 308 * MiB;
constexpr size_t WS_AO = 372 * MiB;
constexpr size_t WS_END = 436 * MiB;
constexpr int CW_TMO = 0, CW_BAR = 4096;
constexpr int MAX_LAUNCHES = 8;
static_assert((CW_BAR + MAX_LAUNCHES * XCD_BAR_WORDS) * 4 <= (int)CTL_ZERO_BYTES, "ctl");
constexpr int RING_BYTES = 131072, LDSX_OFF = RING_BYTES, LDSX_BYTES = 24576, MISC_OFF = LDSX_OFF + LDSX_BYTES, LDS_BYTES = 163840;
constexpr int NWAVES = 8;
constexpr float QSCALE = 0.125f * 1.4426950408889634f;

struct Args { const float* in[18]; float* out; unsigned char* ws; int ph_lo, ph_hi, li, pad; };

struct Frame {
    LAS unsigned char* lds; LAS unsigned char* ldsx;
    int tid, lane, wave;
};
constexpr int GRID = 256;
__device__ __forceinline__ int vcu_of(int bx) { return (bx & 7) * (GRID / 8) + (bx >> 3); }

using pg8::Unit;
struct StaticOrder {
    int nM, nN, nwg, G, c; const char* A; const char* B; size_t tA, tB;
    __device__ void init(int M, int N, int G_, int c_, const void* A_, const void* B_, int lda, int ldb) { nM = M / 256; nN = N / 256; nwg = nM * nN; G = G_; c = c_; A = (const char*)A_; B = (const char*)B_; tA = (size_t)256 * lda * 2; tB = (size_t)256 * ldb * 2; }
    __device__ __forceinline__ bool map(long L, Unit& u) const {
        if (L >= nwg) return false;
        int wgid = (int)L; { const int q = nwg / 8, r = nwg % 8, xcd = wgid % 8, off = wgid / 8; wgid = (xcd < r ? xcd * (q + 1) : r * (q + 1) + (xcd - r) * q) + off; }
        const int nig = 8 * nN, gid = wgid / nig, fm = gid * 8, gsz = (nM - fm) < 8 ? (nM - fm) : 8;
        u.pm = fm + ((wgid % nig) % gsz); u.pn = (wgid % nig) / gsz; u.gi = 0; return true;
    }
    __device__ __forceinline__ bool next(int i, Unit& u) const { return map((long)i * G + c, u); }
    __device__ __forceinline__ void ab(const Unit& u, const char*& a, const char*& b) const { a = A + (size_t)u.pm * tA; b = B + (size_t)u.pn * tB; }
};
struct SchedA {
    int q, pn; const char* A; const char* B;
    __device__ void init(int c, const void* A_, const void* B_) { const int x = c & 7, y = c >> 3; q = 4 * (x >> 1) + (y & 3); pn = 8 * (x & 1) + (y >> 2); A = (const char*)A_; B = (const char*)B_; }
    __device__ __forceinline__ bool next(int i, Unit& u) const { if (i >= 8) return false; u.pm = 8 * q + i; u.pn = pn; u.gi = 0; return true; }
    __device__ __forceinline__ void ab(const Unit& u, const char*& a, const char*& b) const { a = A + (size_t)u.pm * (256 * 1024 * 2); b = B + (size_t)u.pn * (256 * 1024 * 2); }
};
struct SchedB {
    StaticOrder so; bool with_kv; const char* A2; const char* B2;
    __device__ __forceinline__ bool next(int i, Unit& u) const {
        const long L = (long)i * so.G + so.c;
        if (L < so.nwg) return so.map(L, u);
        if (!with_kv || L >= so.nwg + 128) return false;
        u.pm = (int)(L - so.nwg); u.pn = 0; u.gi = 1; return true;
    }
    __device__ __forceinline__ void ab(const Unit& u, const char*& a, const char*& b) const {
        if (u.gi == 0) so.ab(u, a, b); else { a = A2 + (size_t)u.pm * (256 * 1024 * 2); b = B2; }
    }
};
struct SchedW {
    int c; const char* WgT; const char* WuB;
    __device__ __forceinline__ bool next(int i, Unit& u) const { if (i > 0 || c >= 64) return false; u.pm = (c >> 2) & 1; u.pn = c & 3; u.gi = c >> 3; return true; }
    __device__ __forceinline__ void ab(const Unit& u, const char*& a, const char*& b) const {
        const int l = u.gi >> 2, g = u.gi & 3;
        a = WgT + ((size_t)(l * 4 + g) * 512 * 512 + (size_t)u.pm * 256 * 512) * 2;
        b = WuB + ((size_t)l * 1024 * 2048 + (size_t)u.pn * 256 * 2048 + (size_t)g * 512) * 2;
    }
};

using pg8::cvt_pk_bf16;
typedef unsigned u32x4 __attribute__((ext_vector_type(4)));
typedef unsigned u32x2 __attribute__((ext_vector_type(2)));
struct EpiWeff {
    static constexpr bool PERM = true;
    bf16* W1A; const float* a_scale;
    __device__ __forceinline__ void operator()(f32x4 (&acc)[2][2][4][2], const Unit& u, int ui, int wr, int wc, int fr, int fq, int lane, LAS unsigned char* ldsx) const {
        const int l = u.gi >> 2, g = u.gi & 3;
#pragma unroll
        for (int ai = 0; ai < 2; ++ai)
#pragma unroll
            for (int m = 0; m < 4; ++m) {
                const int jj = g * 512 + u.pm * 256 + ai * 128 + wr * 64 + m * 16 + fr;
                const float sc = a_scale[l * 2048 + jj];
                bf16* rowp = W1A + ((size_t)l * 4096 + (size_t)(256 * (jj >> 7) + (jj & 127))) * 1024 + u.pn * 256 + wc * 32 + 8 * fq;
#pragma unroll
                for (int bj = 0; bj < 2; ++bj) { const f32x4 v0 = acc[ai][bj][m][0] * sc, v1 = acc[ai][bj][m][1] * sc;
                    u32x4 w; w.x = cvt_pk_bf16(v0[0], v0[1]); w.y = cvt_pk_bf16(v0[2], v0[3]); w.z = cvt_pk_bf16(v1[0], v1[1]); w.w = cvt_pk_bf16(v1[2], v1[3]);
                    *(u32x4*)(rowp + bj * 128) = w; }
            }
    }
};
struct EpiResid {
    static constexpr bool PERM = false;
    const float* Xin; float* Xout; const float* gate;
    __device__ __forceinline__ void operator()(f32x4 (&acc)[2][2][4][2], const Unit& u, int ui, int wr, int wc, int fr, int fq, int lane, LAS unsigned char* ldsx) const {
        const int row0 = u.pm * 256 + wr * 64 + fr, col0 = u.pn * 256 + wc * 32 + 4 * fq, b = u.pm >> 5;
        f32x4 gv[2][2];
#pragma unroll
        for (int bj = 0; bj < 2; ++bj)
#pragma unroll
            for (int n = 0; n < 2; ++n) gv[bj][n] = *(const f32x4*)(gate + (size_t)b * 3072 + col0 + bj * 128 + n * 16);
#pragma unroll
        for (int ai = 0; ai < 2; ++ai)
#pragma unroll
            for (int m = 0; m < 4; ++m) { const size_t off = (size_t)(row0 + ai * 128 + m * 16) * 1024 + col0;
#pragma unroll
                for (int bj = 0; bj < 2; ++bj)
#pragma unroll
                    for (int n = 0; n < 2; ++n) { const f32x4 xi = *(const f32x4*)(Xin + off + bj * 128 + n * 16); *(f32x4*)(Xout + off + bj * 128 + n * 16) = xi + gv[bj][n] * acc[ai][bj][m][n]; }
                if (m & 1) asm volatile("" ::: "memory"); }
    }
};
struct EpiQZKV {
    static constexpr bool PERM = true;
    bf16* Q; bf16* ZS; bf16* Kb; bf16* Vt;
    __device__ __forceinline__ void operator()(f32x4 (&acc)[2][2][4][2], const Unit& u, int ui, int wr, int wc, int fr, int fq, int lane, LAS unsigned char* ldsx) const {
        const int row0 = u.pm * 256 + wr * 64 + fr;
        if (u.gi == 0) {
            const bool isq = u.pn < 4; bf16* base = isq ? Q : ZS; const int col0 = (u.pn & 3) * 256 + wc * 32 + 8 * fq;
#pragma unroll
            for (int ai = 0; ai < 2; ++ai)
#pragma unroll
                for (int m = 0; m < 4; ++m) { bf16* rowp = base + (size_t)(row0 + ai * 128 + m * 16) * 1024 + col0;
#pragma unroll
                    for (int bj = 0; bj < 2; ++bj) { f32x4 v0 = acc[ai][bj][m][0], v1 = acc[ai][bj][m][1];
                        if (isq) { v0 = v0 * QSCALE; v1 = v1 * QSCALE; }
                        else { v0 = (f32x4){fsilu(v0[0]), fsilu(v0[1]), fsilu(v0[2]), fsilu(v0[3])}; v1 = (f32x4){fsilu(v1[0]), fsilu(v1[1]), fsilu(v1[2]), fsilu(v1[3])}; }
                        u32x4 w; w.x = cvt_pk_bf16(v0[0], v0[1]); w.y = cvt_pk_bf16(v0[2], v0[3]); w.z = cvt_pk_bf16(v1[0], v1[1]); w.w = cvt_pk_bf16(v1[2], v1[3]);
                        *(u32x4*)(rowp + bj * 128) = w; } }
        } else {
            const int b = u.pm >> 5, c0 = wc * 32 + 8 * fq;
#pragma unroll
            for (int ai = 0; ai < 2; ++ai)
#pragma unroll
                for (int m = 0; m < 4; ++m) { const int row = row0 + ai * 128 + m * 16, t = row & (S - 1);
                    { const f32x4 v0 = acc[ai][0][m][0], v1 = acc[ai][0][m][1];
                      u32x4 w; w.x = cvt_pk_bf16(v0[0], v0[1]); w.y = cvt_pk_bf16(v0[2], v0[3]); w.z = cvt_pk_bf16(v1[0], v1[1]); w.w = cvt_pk_bf16(v1[2], v1[3]);
                      *(u32x4*)(Kb + (size_t)row * 128 + c0) = w; }
#pragma unroll
                    for (int n = 0; n < 2; ++n)
#pragma unroll
                        for (int i = 0; i < 4; ++i) { const int v = c0 + 4 * n + i, kvh = v >> 6, d = v & 63;
                            Vt[((size_t)((b * 2 + kvh) * 64 + d)) * S + t] = (bf16)f2bf(acc[ai][1][m][n][i]); }
                }
        }
    }
};

template <int CTRL> __device__ __forceinline__ float dppz(float v) { return __builtin_bit_cast(float, __builtin_amdgcn_update_dpp(0, __builtin_bit_cast(int, v), CTRL, 0xf, 0xf, true)); }
template <int N> __device__ __forceinline__ float row_shr0(float v) { return dppz<0x110 + N>(v); }
template <int N> __device__ __forceinline__ float row_shl0(float v) { return dppz<0x100 + N>(v); }
template <int Dd> __device__ __forceinline__ void dbl_step(f32x4 (&s)[5]) {
#pragma unroll
    for (int m = 4; m >= 1; --m)
#pragma unroll
        for (int i = 0; i < 4; ++i) s[m][i] = s[m][i] + row_shr0<Dd>(s[m][i]) + row_shl0<16 - Dd>(s[m - 1][i]);
#pragma unroll
    for (int i = 0; i < 4; ++i) s[0][i] = s[0][i] + row_shr0<Dd>(s[0][i]);
}
struct EpiPool {
    static constexpr bool PERM = true;
    bf16* V; float* TAIL; float* HEADY; float* HEADZ;
    template <int GI> __device__ __forceinline__ void pool_blocks(f32x4 (&s)[5]) const {
        dbl_step<1>(s);
        if constexpr (GI >= 1) dbl_step<2>(s);
        if constexpr (GI >= 2) dbl_step<4>(s);
        if constexpr (GI >= 3) dbl_step<8>(s);
    }
    __device__ __forceinline__ void operator()(f32x4 (&acc)[2][2][4][2], const Unit& u, int ui, int wr, int wc, int fr, int fq, int lane, LAS unsigned char* ldsx) const {
        const int g = u.pn >> 2;
        if (g == 0) run<0>(acc, u, ui, wr, wc, fr, fq, lane, ldsx); else if (g == 1) run<1>(acc, u, ui, wr, wc, fr, fq, lane, ldsx);
        else if (g == 2) run<2>(acc, u, ui, wr, wc, fr, fq, lane, ldsx); else run<3>(acc, u, ui, wr, wc, fr, fq, lane, ldsx);
    }
    template <int GI> __device__ __forceinline__ void run(f32x4 (&acc)[2][2][4][2], const Unit& u, int ui, int wr, int wc, int fr, int fq, int lane, LAS unsigned char* ldsx) const {
        constexpr int g = GI, w = 2 << g; const int t0 = (u.pm & 31) * 256;
        const bool first = (ui == 0), lastu = (ui == 7), seq0 = (t0 == 0);
        const int colg = u.pn * 128 + wc * 32 + 8 * fq;
        const int carry_in = 3 + (ui & 1), carry_out = 3 + ((ui + 1) & 1);
#pragma unroll
        for (int ai = 0; ai < 2; ++ai) { const int ch = 2 * ai + wr, slot = ch < 3 ? ch : carry_out;
            const f32x4 v0 = acc[ai][0][3][0], v1 = acc[ai][0][3][1];
            u32x4 wv; wv.x = cvt_pk_bf16(v0[0], v0[1]); wv.y = cvt_pk_bf16(v0[2], v0[3]); wv.z = cvt_pk_bf16(v1[0], v1[1]); wv.w = cvt_pk_bf16(v1[2], v1[3]);
            *(LAS u32x4*)(ldsx + slot * 4096 + wc * 1024 + lane * 16) = wv; }
        if (lastu && wr == 1) { float* tp = TAIL + ((size_t)u.pm * 16 + fr) * 2048 + colg; *(f32x4*)tp = acc[1][0][3][0]; *(f32x4*)(tp + 4) = acc[1][0][3][1]; }
        if (first && !seq0 && wr == 0) { float* hp = HEADY + ((size_t)u.pm * 16 + fr) * 2048 + colg; *(f32x4*)hp = acc[0][0][0][0]; *(f32x4*)(hp + 4) = acc[0][0][0][1];
            float* zp = HEADZ + ((size_t)u.pm * 16 + fr) * 2048 + colg; const f32x4 z0 = acc[0][1][0][0], z1 = acc[0][1][0][1];
            *(f32x4*)zp = (f32x4){fsilu(z0[0]), fsilu(z0[1]), fsilu(z0[2]), fsilu(z0[3])}; *(f32x4*)(zp + 4) = (f32x4){fsilu(z1[0]), fsilu(z1[1]), fsilu(z1[2]), fsilu(z1[3])}; }
        asm volatile("s_waitcnt lgkmcnt(0)" ::: "memory"); __builtin_amdgcn_s_barrier(); asm volatile("" ::: "memory");
        const float invw = 1.f / (float)w;
#pragma unroll
        for (int ai = 0; ai < 2; ++ai) {
            const int ch = 2 * ai + wr; const bool havep = (ch > 0) || (!seq0 && !first);
            u32x4 pw = (u32x4){0u, 0u, 0u, 0u};
            if (havep) pw = *(const LAS u32x4*)(ldsx + (ch > 0 ? ch - 1 : carry_in) * 4096 + wc * 1024 + lane * 16);
            f32x4 yo[4][2];
#pragma unroll
            for (int n = 0; n < 2; ++n) {
                f32x4 s[5];
                const unsigned p0 = n == 0 ? pw.x : pw.z, p1 = n == 0 ? pw.y : pw.w;
                s[0] = (f32x4){__builtin_bit_cast(float, p0 << 16), __builtin_bit_cast(float, p0 & 0xffff0000u), __builtin_bit_cast(float, p1 << 16), __builtin_bit_cast(float, p1 & 0xffff0000u)};
#pragma unroll
                for (int m = 0; m < 4; ++m) { s[m + 1] = acc[ai][0][m][n]; yo[m][n] = acc[ai][0][m][n]; }
                pool_blocks<GI>(s);
#pragma unroll
                for (int m = 0; m < 4; ++m) acc[ai][0][m][n] = s[m + 1];
            }
#pragma unroll
            for (int m = 0; m < 4; ++m) {
                float inv = invw; if (seq0 && ch == 0 && m == 0 && fr < w - 1) inv = 1.f / (float)(fr + 1);
                const int row = u.pm * 256 + ai * 128 + wr * 64 + m * 16 + fr;
                f32x4 o[2];
#pragma unroll
                for (int n = 0; n < 2; ++n) { const f32x4 z = acc[ai][1][m][n], p = acc[ai][0][m][n] * inv - yo[m][n];
                    o[n] = (f32x4){p[0] * fsilu(z[0]), p[1] * fsilu(z[1]), p[2] * fsilu(z[2]), p[3] * fsilu(z[3])}; }
                u32x4 wv; wv.x = cvt_pk_bf16(o[0][0], o[0][1]); wv.y = cvt_pk_bf16(o[0][2], o[0][3]); wv.z = cvt_pk_bf16(o[1][0], o[1][1]); wv.w = cvt_pk_bf16(o[1][2], o[1][3]);
                *(u32x4*)(V + (size_t)row * 2048 + colg) = wv;
            }
        }
    }
};
__device__ __forceinline__ void tr_item(const float* src, int sp, bf16* dst, int dp, LAS float* scr, int lane) {
#pragma unroll 8
    for (int i = 0; i < 32; ++i) { const int kk = 2 * i + (lane >> 5); scr[kk * 33 + (lane & 31)] = src[(size_t)kk * sp + (lane & 31)]; }
    LDS_WAIT(); asm volatile("" ::: "memory");
    const int c = lane & 7;
#pragma unroll
    for (int j = 0; j < 4; ++j) { const int n = (lane >> 3) + 8 * j; const LAS float* s = scr + (8 * c) * 33 + n;
        v4u o; o.x = pk2(s[0 * 33], s[1 * 33]); o.y = pk2(s[2 * 33], s[3 * 33]); o.z = pk2(s[4 * 33], s[5 * 33]); o.w = pk2(s[6 * 33], s[7 * 33]);
        *(v4u*)(dst + (size_t)n * dp + 8 * c) = o; }
    LDS_WAIT(); asm volatile("" ::: "memory");
}
struct PT {
    volatile LAS unsigned* tab;
    __device__ __forceinline__ unsigned long long raw(int i) const { const unsigned lo = __builtin_amdgcn_readfirstlane(tab[2 * i]), hi = __builtin_amdgcn_readfirstlane(tab[2 * i + 1]); return ((unsigned long long)hi << 32) | lo; }
    __device__ __forceinline__ const float* in(int i) const { return (const float*)raw(i); }
    __device__ __forceinline__ float* out() const { return (float*)raw(18); }
    __device__ __forceinline__ unsigned char* ws() const { return (unsigned char*)raw(19); }
    __device__ __forceinline__ bf16* wsb(size_t off) const { return (bf16*)(ws() + off); }
    __device__ __forceinline__ float* wsf(size_t off) const { return (float*)(ws() + off); }
};
enum { I_X = 0, I_C, I_NORMG, I_ADAW, I_ADAB, I_AWIN, I_AWG, I_ASCALE, I_AWOUT, I_KVNG, I_KVADAW, I_KVADAB, I_WKV, I_BWIN, I_SINKS, I_BWOUT, I_RELB, I_FINALG };
__device__ __forceinline__ void p0_prologue(const Frame& F0, const PT& P) {
    Frame F = F0; asm volatile("" : "+v"(F.tid), "+v"(F.lane));
    LAS float* cact = (LAS float*)(F.lds + 98304);
    LAS float* red = (LAS float*)(F.lds + 114688);
    const int bx0 = opq((int)blockIdx.x);
    if (bx0 < 224) {
        for (int i = F.tid; i < 4096; i += 512) { const int b = i >> 10, k = i & 1023; const float cv = P.in(I_C)[b * 1024 + k]; cact[k * 4 + b] = cv / (1.f + expf(-cv)); }
        __syncthreads();
        const int gid = bx0 * 64 + F.lane;
        const float* W; int N, n; const float* bias; float* out; int opitch;
        if (gid < 12288) { const int l = gid / 3072; n = gid % 3072; N = 3072; W = P.in(I_ADAW) + (size_t)l * 1024 * 3072; bias = P.in(I_ADAB) + l * 3072; out = P.wsf(WS_MOD) + (size_t)l * 4 * 3072; opitch = 3072; }
        else { n = gid - 12288; N = 2048; W = P.in(I_KVADAW); bias = P.in(I_KVADAB); out = P.wsf(WS_MOD) + 4 * 4 * 3072; opitch = 2048; }
        float a0 = 0.f, a1 = 0.f, a2 = 0.f, a3 = 0.f;
        const int kb = F.wave * 128;
#pragma unroll 8
        for (int k = 0; k < 128; ++k) { const float wv = W[(size_t)(kb + k) * N + n]; const f32x4 cv = *(const LAS f32x4*)(cact + (kb + k) * 4);
            a0 += cv[0] * wv; a1 += cv[1] * wv; a2 += cv[2] * wv; a3 += cv[3] * wv; }
        red[(F.wave * 4 + 0) * 64 + F.lane] = a0; red[(F.wave * 4 + 1) * 64 + F.lane] = a1; red[(F.wave * 4 + 2) * 64 + F.lane] = a2; red[(F.wave * 4 + 3) * 64 + F.lane] = a3;
        __syncthreads();
        if (F.tid < 256) { const int b = F.tid >> 6, cl = F.tid & 63; float s = 0.f;
#pragma unroll
            for (int w = 0; w < 8; ++w) s += red[(w * 4 + b) * 64 + cl];
            out[(size_t)b * opitch + n] = s + bias[n]; }
        __syncthreads();
    }
    LAS float* scr = (LAS float*)(F.lds + F.wave * 8448);
    const int gw = vcu_of(opq((int)blockIdx.x)) * NWAVES + F.wave, NGW = GRID * NWAVES;
    constexpr int J0 = 2048, J1 = 2048, J2 = 128, J3 = 2048, J4 = 1024, J5 = 1024, J6 = 2048;
    for (int it = gw; it < J0 + J1 + J2 + J3 + J4 + J5 + J6; it += NGW) {
        int r = it;
        if (r < J0) { const int l = r >> 10, q = r & 1023, kbk = q >> 6, nb = q & 63, k0 = kbk * 64, n0 = nb * 32;
            tr_item(P.in(I_AWIN) + (size_t)l * 1024 * 4096 + (size_t)k0 * 4096 + 2048 + n0, 4096, P.wsb(WS_W1A) + ((size_t)l * 4096 + 256 * (n0 >> 7) + 128 + (n0 & 127)) * 1024 + k0, 1024, scr, F.lane); continue; } r -= J0;
        if (r < J1) { const int l = r >> 10, q = r & 1023, kbk = q >> 5, nb = q & 31, k0 = kbk * 64, n0 = nb * 32;
            tr_item(P.in(I_AWOUT) + (size_t)l * 2048 * 1024 + (size_t)k0 * 1024 + n0, 1024, P.wsb(WS_W2A) + ((size_t)l * 1024 + n0) * 2048 + k0, 2048, scr, F.lane); continue; } r -= J1;
        if (r < J2) { const int kbk = r >> 3, nb = r & 7, k0 = kbk * 64, n0 = nb * 32;
            tr_item(P.in(I_WKV) + (size_t)k0 * 256 + n0, 256, P.wsb(WS_WKV) + (size_t)n0 * 1024 + k0, 1024, scr, F.lane); continue; } r -= J2;
        if (r < J3) { const int l = r >> 10, q = r & 1023, kbk = q >> 6, nb = q & 63, k0 = kbk * 64, n0 = nb * 32;
            tr_item(P.in(I_BWIN) + (size_t)l * 1024 * 2048 + (size_t)k0 * 2048 + n0, 2048, P.wsb(WS_W1B) + ((size_t)l * 2048 + n0) * 1024 + k0, 1024, scr, F.lane); continue; } r -= J3;
        if (r < J4) { const int l = r >> 9, q = r & 511, kbk = q >> 5, nb = q & 31, k0 = kbk * 64, n0 = nb * 32;
            tr_item(P.in(I_BWOUT) + (size_t)l * 1024 * 1024 + (size_t)k0 * 1024 + n0, 1024, P.wsb(WS_W2B) + ((size_t)l * 1024 + n0) * 1024 + k0, 1024, scr, F.lane); continue; } r -= J4;
        if (r < J5) { const int lg = r >> 7, q = r & 127, kbk = q >> 4, nb = q & 15, k0 = kbk * 64, n0 = nb * 32;
            tr_item(P.in(I_AWG) + (size_t)lg * 512 * 512 + (size_t)k0 * 512 + n0, 512, P.wsb(WS_WGT) + ((size_t)lg * 512 + n0) * 512 + k0, 512, scr, F.lane); continue; } r -= J5;
        { const int l = r >> 10, k = r & 1023; const float* src = P.in(I_AWIN) + (size_t)l * 1024 * 4096 + (size_t)k * 4096; bf16* dst = P.wsb(WS_WUB) + ((size_t)l * 1024 + k) * 2048;
#pragma unroll
          for (int p = 0; p < 4; ++p) { const int c0 = p * 512 + F.lane * 8; const f32x4 a = *(const f32x4*)(src + c0), b = *(const f32x4*)(src + c0 + 4);
              v4u o; o.x = pk2(a[0], a[1]); o.y = pk2(a[2], a[3]); o.z = pk2(b[0], b[1]); o.w = pk2(b[2], b[3]); *(v4u*)(dst + c0) = o; } }
    }
}
template <bool DUAL> __device__ __forceinline__ void norm_pass(const Frame& F0, const float* X, const float* g1, const float* mod1, int p1, bf16* H1, const float* g2, const float* mod2, int p2, bf16* H2) {
    Frame F = F0; asm volatile("" : "+v"(F.lane));
    const int gw = vcu_of(opq((int)blockIdx.x)) * NWAVES + F.wave, NGW = GRID * NWAVES;
    f32x4 v[4], vn[4];
    int row = gw;
    if (row < T) {
#pragma unroll
        for (int j = 0; j < 4; ++j) vn[j] = *((const f32x4*)(X + (size_t)row * D) + F.lane + 64 * j);
    }
    for (; row < T; row += NGW) {
#pragma unroll
        for (int j = 0; j < 4; ++j) v[j] = vn[j];
        const int nr = row + NGW;
        if (nr < T) {
#pragma unroll
            for (int j = 0; j < 4; ++j) vn[j] = *((const f32x4*)(X + (size_t)nr * D) + F.lane + 64 * j);
        }
        float s = 0.f;
#pragma unroll
        for (int j = 0; j < 4; ++j) s += (v[j][0] * v[j][0] + v[j][1] * v[j][1]) + (v[j][2] * v[j][2] + v[j][3] * v[j][3]);
        const float rstd = rsqrtf(wave_sum(s) * (1.f / D) + EPS);
        const int b = row / S;
#pragma unroll
        for (int j = 0; j < 4; ++j) {
            const int k = (F.lane + 64 * j) * 4;
            { const f32x4 gg = *(const f32x4*)(g1 + k), sh = *(const f32x4*)(mod1 + (size_t)b * p1 + k), sc = *(const f32x4*)(mod1 + (size_t)b * p1 + D + k);
              const f32x4 o = v[j] * rstd * gg * (sc + 1.f) + sh; u32x2 w; w.x = pk2(o[0], o[1]); w.y = pk2(o[2], o[3]); *(u32x2*)(H1 + (size_t)row * D + k) = w; }
            if constexpr (DUAL) { const f32x4 gg = *(const f32x4*)(g2 + k), sh = *(const f32x4*)(mod2 + (size_t)b * p2 + k), sc = *(const f32x4*)(mod2 + (size_t)b * p2 + D + k);
              const f32x4 o = v[j] * rstd * gg * (sc + 1.f) + sh; u32x2 w; w.x = pk2(o[0], o[1]); w.y = pk2(o[2], o[3]); *(u32x2*)(H2 + (size_t)row * D + k) = w; }
        }
    }
}
__device__ __forceinline__ void final_norm(const Frame& F0, float* X, const float* g) {
    Frame F = F0; asm volatile("" : "+v"(F.lane));
    const int gw = vcu_of(opq((int)blockIdx.x)) * NWAVES + F.wave, NGW = GRID * NWAVES;
    for (int row = gw; row < T; row += NGW) {
        f32x4 v[4]; float s = 0.f;
#pragma unroll
        for (int j = 0; j < 4; ++j) { v[j] = *((const f32x4*)(X + (size_t)row * D) + F.lane + 64 * j); s += (v[j][0] * v[j][0] + v[j][1] * v[j][1]) + (v[j][2] * v[j][2] + v[j][3] * v[j][3]); }
        const float rstd = rsqrtf(wave_sum(s) * (1.f / D) + EPS);
#pragma unroll
        for (int j = 0; j < 4; ++j) { const int k = (F.lane + 64 * j) * 4; const f32x4 gg = *(const f32x4*)(g + k); *((f32x4*)(X + (size_t)row * D) + F.lane + 64 * j) = v[j] * rstd * gg; }
    }
}
__device__ __forceinline__ void pool_fixup(const Frame& F0, const PT& P) {
    Frame F = F0; asm volatile("" : "+v"(F.tid));
    const float* TAIL = P.wsf(WS_TAIL); const float* HEADY = P.wsf(WS_HEADY); const float* HEADZ = P.wsf(WS_HEADZ); bf16* Vb = P.wsb(WS_V);
    const int gt = vcu_of(opq((int)blockIdx.x)) * 512 + F.tid, NT_ = GRID * 512;
    for (int it = gt; it < 12 * 2048; it += NT_) {
        const int pi = it >> 11, j = it & 2047, qq = (pi / 3) * 4 + (pi % 3) + 1, pm = 8 * qq, g = j >> 9;
        float a[32], zs[16], y0[16], win[16];
#pragma unroll
        for (int r = 0; r < 16; ++r) { a[r] = TAIL[((size_t)(pm - 1) * 16 + r) * 2048 + j]; a[16 + r] = HEADY[((size_t)pm * 16 + r) * 2048 + j]; zs[r] = HEADZ[((size_t)pm * 16 + r) * 2048 + j]; y0[r] = a[16 + r]; }
#pragma unroll
        for (int i = 31; i >= 1; --i) a[i] += a[i - 1];
#pragma unroll
        for (int r = 0; r < 16; ++r) win[r] = a[16 + r];
#pragma unroll
        for (int i = 31; i >= 2; --i) a[i] += a[i - 2];
        if (g >= 1) {
#pragma unroll
            for (int r = 0; r < 16; ++r) win[r] = a[16 + r]; }
#pragma unroll
        for (int i = 31; i >= 4; --i) a[i] += a[i - 4];
        if (g >= 2) {
#pragma unroll
            for (int r = 0; r < 16; ++r) win[r] = a[16 + r]; }
#pragma unroll
        for (int i = 31; i >= 8; --i) a[i] += a[i - 8];
        if (g >= 3) {
#pragma unroll
            for (int r = 0; r < 16; ++r) win[r] = a[16 + r]; }
        const float inv = 1.f / (float)(2 << g);
#pragma unroll
        for (int r = 0; r < 16; ++r) Vb[((size_t)pm * 256 + r) * 2048 + j] = (bf16)f2bf((win[r] * inv - y0[r]) * zs[r]);
    }
}
namespace att {
typedef short bf16x8 __attribute__((ext_vector_type(8)));
typedef short s16x4 __attribute__((ext_vector_type(4)));
typedef float f32x16 __attribute__((ext_vector_type(16)));
constexpr int KS_OFF = 0, KROW = 144, VS_OFF = 36864, VROW = 520, BT_OFF = 70144, BT_N = 192, ST_OFF = 76288, ST_ROWB = 272, ST_WAVE = 32 * ST_ROWB;
static_assert(ST_OFF + 8 * ST_WAVE <= MISC_OFF, "attention LDS map");
constexpr float L2E = 1.4426950408889634f, NEG = -1e30f;
__device__ __forceinline__ int crow(int r, int h) { return (r & 3) + 8 * (r >> 2) + 4 * h; }
__device__ __forceinline__ float xhalf_max(float v) { auto rr = __builtin_amdgcn_permlane32_swap(__float_as_uint(v), __float_as_uint(v), false, false); return fmaxf(__uint_as_float(rr[0]), __uint_as_float(rr[1])); }
__device__ __forceinline__ float xhalf_sum(float v) { auto rr = __builtin_amdgcn_permlane32_swap(__float_as_uint(v), __float_as_uint(v), false, false); return __uint_as_float(rr[0]) + __uint_as_float(rr[1]); }

__device__ __forceinline__ void attn_phase(const Frame& F0, const bf16* Q, const bf16* ZS, const bf16* Kb, const bf16* Vt, const float* sinks, const float* rel_bias, bf16* AO) {
    int tid = F0.tid; asm volatile("" : "+v"(tid));
    const int lane = tid & 63, wave = __builtin_amdgcn_readfirstlane(tid >> 6), q = lane & 31, h = lane >> 5;
    LAS unsigned char* lds = F0.lds;
    const int vcu = vcu_of(opq((int)blockIdx.x));
#pragma unroll 1
    for (int ui = 0; ui < 2; ++ui) {
        const int uid = vcu * 2 + ui, qblk = uid & 63, kvh = (uid >> 6) & 1, b = uid >> 7, t0 = qblk * 128; const bool seq0 = (qblk == 0);
        const size_t R0 = (size_t)b * S + t0;
        { v4u kv[4], vv[4];
#pragma unroll
          for (int p = 0; p < 4; ++p) { const int row = p * 64 + (tid >> 3), ch = tid & 7; kv[p] = (v4u){0u, 0u, 0u, 0u};
              if (!(seq0 && row < 128)) kv[p] = *(const v4u*)(Kb + (R0 - 128 + row) * 128 + kvh * 64 + ch * 8); }
#pragma unroll
          for (int p = 0; p < 4; ++p) { const int d = p * 16 + (tid >> 5), ch = tid & 31; vv[p] = (v4u){0u, 0u, 0u, 0u};
              if (!(seq0 && ch < 16)) vv[p] = *(const v4u*)(Vt + ((size_t)((b * 2 + kvh) * 64 + d)) * S + t0 - 128 + ch * 8); }
          for (int e = tid; e < 8 * BT_N; e += 512) { const int w = e / BT_N, n = e % BT_N - 32;
              ((LAS float*)(lds + BT_OFF))[e] = (n >= 0 && n < 128) ? rel_bias[BUCKET[n] * NH + kvh * 8 + w] * L2E : 0.f; }
#pragma unroll
          for (int p = 0; p < 4; ++p) { const int row = p * 64 + (tid >> 3), ch = tid & 7; *(LAS v4u*)(lds + KS_OFF + row * KROW + ch * 16) = kv[p]; }
#pragma unroll
          for (int p = 0; p < 4; ++p) { const int d = p * 16 + (tid >> 5), ch = tid & 31; LAS unsigned char* dst = lds + VS_OFF + d * VROW + ch * 16;
              *(LAS u32x2*)dst = (u32x2){vv[p].x, vv[p].y}; *(LAS u32x2*)(dst + 8) = (u32x2){vv[p].z, vv[p].w}; }
        }
        __syncthreads();
        const int hq = kvh * 8 + wave; const float sink2 = sinks[hq] * L2E;
        const LAS float* bt = (const LAS float*)(lds + BT_OFF) + wave * BT_N + 32 + q - 4 * h;
        LAS unsigned char* stg = lds + ST_OFF + wave * ST_WAVE;
#pragma unroll 1
        for (int qi = 0; qi < 4; ++qi) {
            const bf16* Qr = Q + (R0 + 32 * qi + q) * 1024 + hq * 64 + 8 * h;
            bf16x8 qf[4];
#pragma unroll
            for (int s = 0; s < 4; ++s) qf[s] = *(const bf16x8*)(Qr + 16 * s);
            f32x16 p[5];
#pragma unroll
            for (int kk = 0; kk < 5; ++kk) {
                const int sb = qi + kk;
#pragma unroll
                for (int r = 0; r < 16; ++r) p[kk][r] = bt[128 - 32 * kk - ((r & 3) + 8 * (r >> 2))];
                const LAS unsigned char* kp = lds + KS_OFF + (32 * sb + q) * KROW + h * 16;
#pragma unroll
                for (int s = 0; s < 4; ++s) { const bf16x8 kf = *(const LAS bf16x8*)(kp + s * 32); p[kk] = __builtin_amdgcn_mfma_f32_32x32x16_bf16(kf, qf[s], p[kk], 0, 0, 0); }
            }
#pragma unroll
            for (int r = 0; r < 16; ++r) { const int cr = crow(r, h); if (cr <= q) p[0][r] = NEG; if (cr > q) p[4][r] = NEG; }
            if (seq0) {
#pragma unroll
                for (int kk = 0; kk < 4; ++kk) if (qi + kk < 4) {
#pragma unroll
                    for (int r = 0; r < 16; ++r) p[kk][r] = NEG; }
            }
            float m = sink2;
#pragma unroll
            for (int kk = 0; kk < 5; ++kk)
#pragma unroll
                for (int r = 0; r < 16; ++r) m = fmaxf(m, p[kk][r]);
            m = xhalf_max(m);
            float l = 0.f;
#pragma unroll
            for (int kk = 0; kk < 5; ++kk)
#pragma unroll
                for (int r = 0; r < 16; ++r) { p[kk][r] = __builtin_amdgcn_exp2f(p[kk][r] - m); l += p[kk][r]; }
            l = xhalf_sum(l) + __builtin_amdgcn_exp2f(sink2 - m);
            const float il = __builtin_amdgcn_rcpf(l);
            f32x16 o[2];
#pragma unroll
            for (int d0 = 0; d0 < 2; ++d0)
#pragma unroll
                for (int r = 0; r < 16; ++r) o[d0][r] = 0.f;
#pragma unroll
            for (int kk = 0; kk < 5; ++kk) {
                const int sb = qi + kk;
#pragma unroll
                for (int s2 = 0; s2 < 2; ++s2) {
                    u32x4 pw; pw.x = cvt_pk_bf16(p[kk][8 * s2 + 0], p[kk][8 * s2 + 1]); pw.y = cvt_pk_bf16(p[kk][8 * s2 + 2], p[kk][8 * s2 + 3]);
                    pw.z = cvt_pk_bf16(p[kk][8 * s2 + 4], p[kk][8 * s2 + 5]); pw.w = cvt_pk_bf16(p[kk][8 * s2 + 6], p[kk][8 * s2 + 7]);
                    const bf16x8 pf = __builtin_bit_cast(bf16x8, pw);
#pragma unroll
                    for (int d0 = 0; d0 < 2; ++d0) {
                        const LAS unsigned char* vp = lds + VS_OFF + (32 * d0 + q) * VROW + (32 * sb + 16 * s2 + 4 * h) * 2;
                        const s16x4 lo = *(const LAS s16x4*)vp, hi = *(const LAS s16x4*)(vp + 16);
                        const bf16x8 vf = (bf16x8){lo[0], lo[1], lo[2], lo[3], hi[0], hi[1], hi[2], hi[3]};
                        o[d0] = __builtin_amdgcn_mfma_f32_32x32x16_bf16(vf, pf, o[d0], 0, 0, 0);
                    }
                }
            }
#pragma unroll
            for (int d0 = 0; d0 < 2; ++d0)
#pragma unroll
                for (int rg = 0; rg < 4; ++rg)
                    *(LAS f32x4*)(stg + q * ST_ROWB + (32 * d0 + 8 * rg + 4 * h) * 4) = (f32x4){o[d0][4 * rg] * il, o[d0][4 * rg + 1] * il, o[d0][4 * rg + 2] * il, o[d0][4 * rg + 3] * il};
            LDS_WAIT(); asm volatile("" ::: "memory");
#pragma unroll
            for (int i = 0; i < 4; ++i) { const int row = i * 8 + (lane >> 3), ch = lane & 7; const size_t goff = (R0 + 32 * qi + row) * 1024 + hq * 64 + ch * 8;
                const v4u zz = *(const v4u*)(ZS + goff);
                const f32x4 a0 = *(const LAS f32x4*)(stg + row * ST_ROWB + ch * 32), a1 = *(const LAS f32x4*)(stg + row * ST_ROWB + ch * 32 + 16);
                v4u w; w.x = cvt_pk_bf16(a0[0] * __uint_as_float(zz.x << 16), a0[1] * __uint_as_float(zz.x & 0xffff0000u)); w.y = cvt_pk_bf16(a0[2] * __uint_as_float(zz.y << 16), a0[3] * __uint_as_float(zz.y & 0xffff0000u));
                w.z = cvt_pk_bf16(a1[0] * __uint_as_float(zz.z << 16), a1[1] * __uint_as_float(zz.z & 0xffff0000u)); w.w = cvt_pk_bf16(a1[2] * __uint_as_float(zz.w << 16), a1[3] * __uint_as_float(zz.w & 0xffff0000u));
                *(v4u*)(AO + goff) = w; }
            LDS_WAIT(); asm volatile("" ::: "memory");
        }
        __syncthreads();
    }
}
}
__global__ void __launch_bounds__(256) k_attn2(const bf16* Q, const bf16* ZS, const bf16* Kb, const bf16* Vt, const float* sinks, const float* rel_bias, bf16* AO) {
    const int gid = blockIdx.x * 256 + threadIdx.x, hq = gid & 15, row = gid >> 4, t = row % S, b = row / S, kvh = hq >> 3;
    float q[64], o[64];
#pragma unroll
    for (int d = 0; d < 64; ++d) { q[d] = bf2f(Q[(size_t)row * D + hq * 64 + d]); o[d] = 0.f; }
    const float L2E = 1.4426950408889634f;
    float m = sinks[hq] * L2E, l = 1.f;
    const int nk = (t + 1 < WIN) ? t + 1 : WIN;
    const bf16* vb = Vt + (size_t)((b * 2 + kvh) * 64) * S;
    for (int i = 0; i < nk; ++i) {
        const bf16* kr = Kb + (size_t)(row - i) * 128 + kvh * 64;
        float s = 0.f;
#pragma unroll
        for (int d = 0; d < 64; ++d) s += q[d] * bf2f(kr[d]);
        s += rel_bias[BUCKET[i] * NH + hq] * L2E;
        const float mn = fmaxf(m, s), corr = exp2f(m - mn), p = exp2f(s - mn);
        l = l * corr + p; m = mn;
#pragma unroll
        for (int d = 0; d < 64; ++d) o[d] = o[d] * corr + p * bf2f(vb[(size_t)d * S + (t - i)]);
    }
    const float il = 1.f / l;
#pragma unroll
    for (int d = 0; d < 64; ++d) AO[(size_t)row * D + hq * 64 + d] = (bf16)f2bf(o[d] * il * bf2f(ZS[(size_t)row * D + hq * 64 + d]));
}

__global__ void __launch_bounds__(NWAVES * 64, 2) mk_fwd(Args args) {
    extern __shared__ __attribute__((aligned(16))) unsigned char lds_raw[];
    Frame F;
    F.lds = (LAS unsigned char*)lds_raw; F.ldsx = F.lds + LDSX_OFF;
    volatile LAS unsigned* MISC = (volatile LAS unsigned*)(F.lds + MISC_OFF);
    F.tid = threadIdx.x; F.lane = F.tid & 63; F.wave = __builtin_amdgcn_readfirstlane(F.tid >> 6);
    for (int u = F.tid; u < (LDS_BYTES - MISC_OFF) / 4; u += NWAVES * 64) ((LAS unsigned*)(F.lds + MISC_OFF))[u] = 0u;
    __syncthreads();
    { volatile LAS unsigned long long* t64 = (volatile LAS unsigned long long*)(F.lds + MISC_OFF + 64);
      if (F.tid < 18) t64[F.tid] = (unsigned long long)args.in[F.tid]; else if (F.tid == 18) t64[18] = (unsigned long long)args.out; else if (F.tid == 19) t64[19] = (unsigned long long)args.ws; }
    __syncthreads();
    PT P{(volatile LAS unsigned*)(F.lds + MISC_OFF + 64)};
    unsigned* ctl = (unsigned*)(P.ws() + WS_CTL);
    XcdBarrier bar = xcd_barrier_post(ctl + CW_BAR + args.li * XCD_BAR_WORDS, MISC + 8);
    const int lo = args.ph_lo, hi = args.ph_hi;
#define IN(k) (lo <= (k) && (k) < hi)
#define SEAM(k) do { if (IN(k) && IN((k) + 1)) xcd_barrier(bar); } while (0)

    if (IN(0)) { p0_prologue(F, P); } SEAM(0);
    if (IN(1)) {
        { SchedW Sw{opq((int)blockIdx.x), (const char*)P.wsb(WS_WGT), (const char*)P.wsb(WS_WUB)}; EpiWeff E{P.wsb(WS_W1A), P.in(I_ASCALE)};
          pg8::gemm_phase<512, 512, 2048, EpiWeff, SchedW>(F.lds, F.ldsx, Sw, E); }
        norm_pass<false>(F, P.in(I_X), P.in(I_NORMG), P.wsf(WS_MOD), 3072, P.wsb(WS_H), nullptr, nullptr, 0, nullptr);
    } SEAM(1);
#pragma unroll 1
    for (int l = 0; l < 2; ++l) {
        const int base = 2 + 4 * l;
        if (IN(base)) { SchedA Sa; Sa.init(opq((int)blockIdx.x), P.wsb(WS_H), P.wsb(WS_W1A) + (size_t)l * 4096 * 1024); EpiPool E{P.wsb(WS_V), P.wsf(WS_TAIL), P.wsf(WS_HEADY), P.wsf(WS_HEADZ)};
            pg8::gemm_phase<1024, 1024, 1024, EpiPool, SchedA>(F.lds, F.ldsx, Sa, E); } SEAM(base);
        if (IN(base + 1)) { pool_fixup(F, P); } SEAM(base + 1);
        if (IN(base + 2)) { StaticOrder So; So.init(T, 1024, GRID, opq((int)blockIdx.x), P.wsb(WS_V), P.wsb(WS_W2A) + (size_t)l * 1024 * 2048, 2048, 2048);
            EpiResid E{l == 0 ? P.in(I_X) : (const float*)P.out(), P.out(), P.wsf(WS_MOD) + (size_t)l * 4 * 3072 + 2048};
            pg8::gemm_phase<2048, 2048, 2048, EpiResid, StaticOrder>(F.lds, F.ldsx, So, E); } SEAM(base + 2);
        if (IN(base + 3)) {
            if (l == 0) norm_pass<false>(F, P.out(), P.in(I_NORMG) + 1024, P.wsf(WS_MOD) + (size_t)1 * 4 * 3072, 3072, P.wsb(WS_H), nullptr, nullptr, 0, nullptr);
            else norm_pass<true>(F, P.out(), P.in(I_NORMG) + 2048, P.wsf(WS_MOD) + (size_t)2 * 4 * 3072, 3072, P.wsb(WS_H), P.in(I_KVNG), P.wsf(WS_MOD) + 4 * 4 * 3072, 2048, P.wsb(WS_HK));
        } SEAM(base + 3);
    }
#pragma unroll 1
    for (int j = 0; j < 2; ++j) {
        const int base = 10 + 4 * j, l = 2 + j;
        if (IN(base)) { SchedB Sb; Sb.so.init(T, 2048, GRID, opq((int)blockIdx.x), P.wsb(WS_H), P.wsb(WS_W1B) + (size_t)j * 2048 * 1024, 1024, 1024); Sb.with_kv = (j == 0); Sb.A2 = (const char*)P.wsb(WS_HK); Sb.B2 = (const char*)P.wsb(WS_WKV);
            EpiQZKV E{P.wsb(WS_V), P.wsb(WS_V + 64 * MiB), P.wsb(WS_K), P.wsb(WS_VT)};
            pg8::gemm_phase<1024, 1024, 1024, EpiQZKV, SchedB>(F.lds, F.ldsx, Sb, E); } SEAM(base);
        if (IN(base + 1)) { att::attn_phase(F, P.wsb(WS_V), P.wsb(WS_V + 64 * MiB), P.wsb(WS_K), P.wsb(WS_VT), P.in(I_SINKS) + j * NH, P.in(I_RELB), P.wsb(WS_AO)); } SEAM(base + 1);
        if (IN(base + 2)) { StaticOrder So; So.init(T, 1024, GRID, opq((int)blockIdx.x), P.wsb(WS_AO), P.wsb(WS_W2B) + (size_t)j * 1024 * 1024, 1024, 1024);
            EpiResid E{P.out(), P.out(), P.wsf(WS_MOD) + (size_t)l * 4 * 3072 + 2048};
            pg8::gemm_phase<1024, 1024, 1024, EpiResid, StaticOrder>(F.lds, F.ldsx, So, E); } SEAM(base + 2);
        if (IN(base + 3)) {
            if (j == 0) norm_pass<false>(F, P.out(), P.in(I_NORMG) + 3072, P.wsf(WS_MOD) + (size_t)3 * 4 * 3072, 3072, P.wsb(WS_H), nullptr, nullptr, 0, nullptr);
            else final_norm(F, P.out(), P.in(I_FINALG));
        } SEAM(base + 3);
    }
#undef IN
#undef SEAM
}

extern "C" void kernel_launch(void* const* d_in, const int* in_sizes, int n_in, void* d_out, int out_size, void* d_ws, size_t ws_size, hipStream_t stream) {
    static int grid = 0;
    if (grid == 0) {
        if (n_in != 18 || out_size != T * D || ws_size < WS_END) { fprintf(stderr, "kernel_launch: unexpected shapes (n_in %d, out %d, ws %zu)\n", n_in, out_size, ws_size); grid = -1; return; }
        int dev = 0, cus = 0, per_cu = 0;
        hipGetDevice(&dev); hipDeviceGetAttribute(&cus, hipDeviceAttributeMultiprocessorCount, dev);
        if (hipFuncSetAttribute((const void*)mk_fwd, hipFuncAttributeMaxDynamicSharedMemorySize, LDS_BYTES) != hipSuccess) { fprintf(stderr, "kernel_launch: hipFuncSetAttribute failed\n"); grid = -1; return; }
        hipOccupancyMaxActiveBlocksPerMultiprocessor(&per_cu, (const void*)mk_fwd, NWAVES * 64, LDS_BYTES);
        (void)hipGetLastError();
        if (per_cu < 1) { fprintf(stderr, "kernel_launch: occupancy query says %d blocks per CU\n", per_cu); per_cu = 1; }
        grid = cus * 1;
        if (grid != 256) fprintf(stderr, "kernel_launch: %d CUs; the schedules assume 256\n", cus);
    }
    if (grid < 0) return;
    hipMemsetAsync((char*)d_ws + WS_CTL, 0, CTL_ZERO_BYTES, stream);
    Args a{};
    for (int i = 0; i < 18; ++i) a.in[i] = (const float*)d_in[i];
    a.out = (float*)d_out; a.ws = (unsigned char*)d_ws;
    unsigned char* ws = (unsigned char*)d_ws;
    const bf16* Q = (const bf16*)(ws + WS_V); const bf16* ZS = (const bf16*)(ws + WS_V + 64 * MiB);
    a.ph_lo = 0; a.ph_hi = 18; a.li = 0;
    hipLaunchKernelGGL(mk_fwd, dim3(grid), dim3(NWAVES * 64), LDS_BYTES, stream, a);
}
```

```cpp
#define REP_SEL 0
#include <hip/hip_runtime.h>
#include <cstdint>
#include <cstdio>

typedef unsigned short bf16;
constexpr int D = 1024, NB = 4, S = 8192, T = NB * S, DEPTH = 4, NA = 2, E = 2048, GW = 512, HD = 64, NH = 16, NKV = 2, WIN = 128;
constexpr float EPS = 1e-6f;

__device__ const unsigned char BUCKET[128] = {0, 1, 2, 3, 4, 5, 6, 7, 8, 9, 10, 11, 12, 13, 14, 15, 16, 16, 16, 17, 17, 18, 18, 18, 19, 19, 19, 20, 20, 20, 20, 21, 21, 21, 21, 22, 22, 22, 22, 22, 23, 23, 23, 23, 23, 23, 24, 24, 24, 24, 24, 24, 25, 25, 25, 25, 25, 25, 25, 26, 26, 26, 26, 26, 26, 26, 26, 27, 27, 27, 27, 27, 27, 27, 27, 27, 27, 28, 28, 28, 28, 28, 28, 28, 28, 28, 28, 29, 29, 29, 29, 29, 29, 29, 29, 29, 29, 29, 29, 30, 30, 30, 30, 30, 30, 30, 30, 30, 30, 30, 30, 30, 30, 31, 31, 31, 31, 31, 31, 31, 31, 31, 31, 31, 31, 31, 31, 31};

__device__ __forceinline__ unsigned f2bf(float f) { unsigned u = __builtin_bit_cast(unsigned, f); return (u + 0x7fffu + ((u >> 16) & 1u)) >> 16; }
__device__ __forceinline__ float bf2f(unsigned short b) { return __builtin_bit_cast(float, (unsigned)b << 16); }
__device__ __forceinline__ float silu(float v) { return v / (1.f + expf(-v)); }

__device__ __forceinline__ int lane_id_v() { int l; asm volatile("v_mbcnt_lo_u32_b32 %0, -1, 0\n\tv_mbcnt_hi_u32_b32 %0, -1, %0" : "=v"(l)); return l; }
__device__ __forceinline__ float bperm_xor(float v, int lane, int mask) { return __builtin_bit_cast(float, __builtin_amdgcn_ds_bpermute((lane ^ mask) << 2, __builtin_bit_cast(int, v))); }
__device__ __forceinline__ float wave_sum(float v, int lane) {
#pragma unroll
    for (int o = 1; o < 64; o <<= 1) v += bperm_xor(v, lane, o);
    return v;
}
namespace pg8 {
#define PG8_LAS __attribute__((address_space(3)))
typedef unsigned short bf16_t;
typedef short bf16x8 __attribute__((ext_vector_type(8)));
typedef float f32x4 __attribute__((ext_vector_type(4)));
typedef float f32x2 __attribute__((ext_vector_type(2)));
typedef unsigned u32x4 __attribute__((ext_vector_type(4)));
typedef unsigned u32x2 __attribute__((ext_vector_type(2)));
constexpr int BM = 256, BK = 64, HALF = 128, HTB = HALF * BK * 2  , STAGE_BYTES = 8 * HTB, NXCD = 8, WGM = 8;

__host__ __device__ __forceinline__ int lds_byte(int r, int c) { const int st = (r >> 4) * 2 + (c >> 5), rr = r & 15, cc = c & 31, ob = rr * 64 + cc * 2; return st * 1024 + (ob ^ (((ob >> 9) & 1) << 5)); }
__host__ __device__ __forceinline__ void stage_rc(int b, int& R, int& C) { const int st = b / 1024, sb = b % 1024, swz = sb ^ (((sb >> 9) & 1) << 5); R = (st >> 1) * 16 + swz / 64; C = (st & 1) * 32 + (swz % 64) / 2; }
__host__ __device__ __forceinline__ int perm32(int rho) { const int n = rho >> 4, i = rho & 15; return 8 * (i >> 2) + 4 * n + (i & 3); }

struct Unit { int pm, pn, gi; };

__device__ __forceinline__ unsigned cvt_pk_bf16(float lo, float hi) { unsigned r; asm volatile("v_cvt_pk_bf16_f32 %0, %1, %2" : "=v"(r) : "v"(lo), "v"(hi)); return r; }

template <int K, int LDA, int LDB, class Epi, class Sched, bool ALIGN_EPI = true, bool SP2 = true>
__device__ __forceinline__ void gemm_phase(PG8_LAS unsigned char* lds, PG8_LAS unsigned char* ldsx, int wave_sgpr, const Sched& S, const Epi& E) {
    const int lane_ = lane_id_v();
    const int wid = wave_sgpr, lane = lane_, tid = wid * 64 + lane, wr = wid >> 2, wc = wid & 3, fr = lane & 15, fq = lane >> 4;
    constexpr int nt = K / BK;
    unsigned voffA[2], voffB[2];
#pragma unroll
    for (int i = 0; i < 2; ++i) { int R, C; stage_rc(tid * 16 + i * 8192, R, C); const int Rb = Epi::PERM ? ((R & ~31) + perm32(R & 31)) : R;
        voffA[i] = (unsigned)(R * LDA + C) * 2u; voffB[i] = (unsigned)(Rb * LDB + C) * 2u; }
    constexpr size_t kstep = (size_t)(BK * 2);
    constexpr size_t hstepA = (size_t)HALF * LDA * 2, hstepB = (size_t)HALF * LDB * 2;
    const unsigned ldsw = (unsigned)wid * 1024u;
    const int aoff = lds_byte(wr * 64 + fr, fq * 8), boff = lds_byte(wc * 32 + fr, fq * 8);
#define PG8_SA(b, h) (((b) * 2 + (h)) * HTB)
#define PG8_SB(b, h) ((4 + (b) * 2 + (h)) * HTB)
#define PG8_STAGE(bufoff, gbase, voff) do { _Pragma("unroll") for (int _i = 0; _i < 2; ++_i) \
        __builtin_amdgcn_global_load_lds((const unsigned*)((const char*)(gbase) + (voff)[_i]), (PG8_LAS unsigned*)(lds + (bufoff) + ldsw + _i * 8192), 16, 0, 0); } while (0)
#define PG8_LDA(dst, b, h) do { _Pragma("unroll") for (int m = 0; m < 4; ++m) _Pragma("unroll") for (int k = 0; k < 2; ++k) dst[m][k] = *(const PG8_LAS bf16x8*)(lds + PG8_SA(b, h) + aoff + m * 2048 + k * 1024); } while (0)
#define PG8_LDB(dst, b, h) do { _Pragma("unroll") for (int n = 0; n < 2; ++n) _Pragma("unroll") for (int k = 0; k < 2; ++k) dst[n][k] = *(const PG8_LAS bf16x8*)(lds + PG8_SB(b, h) + boff + n * 2048 + k * 1024); } while (0)
#define PG8_MMA(ai, bj, At, Bt) do { __builtin_amdgcn_s_setprio(1); _Pragma("unroll") for (int m = 0; m < 4; ++m) _Pragma("unroll") for (int n = 0; n < 2; ++n) _Pragma("unroll") for (int k = 0; k < 2; ++k) \
        acc[ai][bj][m][n] = __builtin_amdgcn_mfma_f32_16x16x32_bf16(Bt[n][k], At[m][k], acc[ai][bj][m][n], 0, 0, 0); __builtin_amdgcn_s_setprio(0); } while (0)
#define PG8_WAIT_V(n) asm volatile("s_waitcnt vmcnt(" #n ")" ::: "memory")
#define PG8_WAIT_L(n) asm volatile("s_waitcnt lgkmcnt(" #n ")" ::: "memory")
#define PG8_BAR __builtin_amdgcn_s_barrier()
#define PG8_SCHED __builtin_amdgcn_sched_barrier(0)
    Unit cur, nxt; int ui = 0;
    if (!S.next(0, cur)) return;
    f32x4 acc[2][2][4][2];
#pragma unroll
    for (int a = 0; a < 2; ++a)
#pragma unroll
        for (int b = 0; b < 2; ++b)
#pragma unroll
            for (int m = 0; m < 4; ++m)
#pragma unroll
                for (int n = 0; n < 2; ++n) acc[a][b][m][n] = (f32x4){0.f, 0.f, 0.f, 0.f};
    bf16x8 At[4][2], B0[2][2], B1[2][2];
    const char* cA; const char* cB; S.ab(cur, cA, cB);
    if constexpr (SP2) {
        PG8_STAGE(PG8_SB(0, 0), cB, voffB); PG8_STAGE(PG8_SB(0, 1), cB + hstepB, voffB); PG8_STAGE(PG8_SA(0, 0), cA, voffA); PG8_STAGE(PG8_SA(0, 1), cA + hstepA, voffA);
        if (wr == 1) PG8_BAR;
        PG8_WAIT_V(2); PG8_BAR;
        PG8_STAGE(PG8_SB(1, 0), cB + kstep, voffB); PG8_STAGE(PG8_SA(1, 0), cA + kstep, voffA); PG8_STAGE(PG8_SB(1, 1), cB + hstepB + kstep, voffB);
        PG8_WAIT_V(6); PG8_BAR;
    } else {
        PG8_STAGE(PG8_SB(0, 0), cB, voffB); PG8_STAGE(PG8_SA(0, 0), cA, voffA); PG8_STAGE(PG8_SB(0, 1), cB + hstepB, voffB); PG8_STAGE(PG8_SA(0, 1), cA + hstepA, voffA);
        if (wr == 1) PG8_BAR;
        PG8_WAIT_V(4); PG8_BAR;
        PG8_STAGE(PG8_SB(1, 0), cB + kstep, voffB); PG8_STAGE(PG8_SA(1, 0), cA + kstep, voffA); PG8_STAGE(PG8_SB(1, 1), cB + hstepB + kstep, voffB);
        PG8_WAIT_V(6); PG8_BAR;
    }
    for (;;) {
        const bool has_next = S.next(ui + 1, nxt);
        const char* nA = cA; const char* nB = cB; if (has_next) S.ab(nxt, nA, nB);
        for (int t = 0; t < nt; t += 2) {
            const bool last = (t == nt - 2);
            const char* a1 = cA + (size_t)(t + 1) * kstep;
            const char* a2 = last ? nA : cA + (size_t)(t + 2) * kstep; const char* b2 = last ? nB : cB + (size_t)(t + 2) * kstep;
            const char* a3 = a2 + kstep; const char* b3 = b2 + kstep;
            if constexpr (SP2) {
            PG8_LDB(B0, 0, 0); PG8_LDB(B1, 0, 1); PG8_SCHED; PG8_LDA(At, 0, 0); PG8_STAGE(PG8_SA(1, 1), a1 + hstepA, voffA);
            PG8_WAIT_V(8); PG8_WAIT_L(0); PG8_BAR; PG8_MMA(0, 0, At, B0); PG8_MMA(0, 1, At, B1); PG8_BAR; PG8_SCHED;
            PG8_LDA(At, 0, 1); PG8_STAGE(PG8_SB(0, 0), b2, voffB); PG8_STAGE(PG8_SB(0, 1), b2 + hstepB, voffB); PG8_STAGE(PG8_SA(0, 0), a2, voffA);
            PG8_WAIT_V(8); PG8_WAIT_L(0); PG8_BAR; PG8_MMA(1, 0, At, B0); PG8_MMA(1, 1, At, B1); PG8_BAR; PG8_SCHED;
            PG8_LDB(B0, 1, 0); PG8_LDB(B1, 1, 1); PG8_SCHED; PG8_LDA(At, 1, 0); PG8_STAGE(PG8_SA(0, 1), a2 + hstepA, voffA);
            PG8_WAIT_V(8); PG8_WAIT_L(0); PG8_BAR; PG8_MMA(0, 0, At, B0); PG8_MMA(0, 1, At, B1); PG8_BAR; PG8_SCHED;
            PG8_LDA(At, 1, 1); PG8_STAGE(PG8_SB(1, 0), b3, voffB); PG8_STAGE(PG8_SB(1, 1), b3 + hstepB, voffB); PG8_STAGE(PG8_SA(1, 0), a3, voffA);
            PG8_WAIT_V(8); PG8_WAIT_L(0); PG8_BAR; PG8_MMA(1, 0, At, B0); PG8_MMA(1, 1, At, B1); PG8_BAR; PG8_SCHED;
            } else {
            PG8_LDB(B0, 0, 0); PG8_SCHED; PG8_LDA(At, 0, 0); PG8_STAGE(PG8_SA(1, 1), a1 + hstepA, voffA);
            PG8_WAIT_L(8); PG8_BAR; PG8_WAIT_L(0); PG8_MMA(0, 0, At, B0); PG8_BAR; PG8_SCHED;
            PG8_LDB(B1, 0, 1); PG8_STAGE(PG8_SB(0, 0), b2, voffB);
            PG8_BAR; PG8_WAIT_L(0); PG8_MMA(0, 1, At, B1); PG8_BAR;
            PG8_LDA(At, 0, 1); PG8_STAGE(PG8_SA(0, 0), a2, voffA);
            PG8_BAR; PG8_WAIT_L(0); PG8_MMA(1, 0, At, B0); PG8_BAR; PG8_SCHED;
            PG8_STAGE(PG8_SB(0, 1), b2 + hstepB, voffB);
            PG8_WAIT_V(6); PG8_BAR; PG8_MMA(1, 1, At, B1); PG8_BAR;
            PG8_LDB(B0, 1, 0); PG8_SCHED; PG8_LDA(At, 1, 0); PG8_STAGE(PG8_SA(0, 1), a2 + hstepA, voffA);
            PG8_WAIT_L(8); PG8_BAR; PG8_WAIT_L(0); PG8_MMA(0, 0, At, B0); PG8_BAR; PG8_SCHED;
            PG8_LDB(B1, 1, 1); PG8_STAGE(PG8_SB(1, 0), b3, voffB);
            PG8_BAR; PG8_WAIT_L(0); PG8_MMA(0, 1, At, B1); PG8_BAR;
            PG8_LDA(At, 1, 1); PG8_STAGE(PG8_SA(1, 0), a3, voffA);
            PG8_BAR; PG8_WAIT_L(0); PG8_MMA(1, 0, At, B0); PG8_BAR; PG8_SCHED;
            PG8_STAGE(PG8_SB(1, 1), b3 + hstepB, voffB);
            PG8_WAIT_V(6); PG8_BAR; PG8_MMA(1, 1, At, B1); PG8_BAR;
            }
        }
        if constexpr (ALIGN_EPI) { if (wr == 0) PG8_BAR; }
        { int lane_e = lane_id_v(), wr_e = wr, wc_e = wc;
          asm volatile("" : "+s"(wr_e), "+s"(wc_e)); const int fr_e = lane_e & 15, fq_e = lane_e >> 4;
          E(acc, cur, ui, wr_e, wc_e, fr_e, fq_e, lane_e, ldsx); }
        if (!has_next) break;
#pragma unroll
        for (int a = 0; a < 2; ++a)
#pragma unroll
            for (int b = 0; b < 2; ++b)
#pragma unroll
                for (int m = 0; m < 4; ++m)
#pragma unroll
                    for (int n = 0; n < 2; ++n) acc[a][b][m][n] = (f32x4){0.f, 0.f, 0.f, 0.f};
        cur = nxt; cA = nA; cB = nB; ++ui;
        if constexpr (ALIGN_EPI) { if (wr == 1) PG8_BAR; }
    }
    PG8_WAIT_V(0);
    if constexpr (!ALIGN_EPI) { if (wr == 0) PG8_BAR; }
    PG8_BAR;
#undef PG8_SA
#undef PG8_SB
#undef PG8_STAGE
#undef PG8_LDA
#undef PG8_LDB
#undef PG8_MMA
#undef PG8_WAIT_V
#undef PG8_WAIT_L
#undef PG8_BAR
#undef PG8_SCHED
}
}
#define GAS __attribute__((address_space(1)))
#define LAS __attribute__((address_space(3)))
typedef unsigned v4u __attribute__((ext_vector_type(4)));
typedef float f32x4 __attribute__((ext_vector_type(4)));
typedef GAS unsigned gu32;
#define RLX_AGENT __ATOMIC_RELAXED, __HIP_MEMORY_SCOPE_AGENT
#define LDS_WAIT() asm volatile("s_waitcnt lgkmcnt(0)" ::: "memory")
#define VM_WAIT() asm volatile("s_waitcnt vmcnt(0)" ::: "memory")
__device__ __forceinline__ unsigned pk2(float lo, float hi) { return f2bf(lo) | (f2bf(hi) << 16); }
__device__ __forceinline__ float fsilu(float v) { return v * __builtin_amdgcn_rcpf(1.f + __builtin_amdgcn_exp2f(-1.4426950408889634f * v)); }

__device__ __forceinline__ int opq(int v) { asm volatile("" : "+s"(v)); return v; }
template <class Tp> __device__ __forceinline__ Tp* opqp(Tp* p) { unsigned long long v = (unsigned long long)p; unsigned lo = (unsigned)v, hi = (unsigned)(v >> 32); asm volatile("" : "+s"(lo), "+s"(hi)); return (Tp*)(((unsigned long long)hi << 32) | lo); }
#define XB_TMO      128
#define XB_XCNT(j)  (256  + 64 * (j))
#define XB_XSUB(j)  (1280 + 64 * (j))
#define XB_XGEN(j)  (2304 + 64 * (j))
#define XB_TOP      3328
#define XB_TOPGEN   3392
#define XCD_BAR_WORDS 3456
#define XB_SPIN_CAP (1u << 18)
__device__ __forceinline__ unsigned xb_ld(unsigned* p)              { return __hip_atomic_load(p, __ATOMIC_RELAXED, __HIP_MEMORY_SCOPE_AGENT); }
__device__ __forceinline__ unsigned xb_add(unsigned* p, unsigned v) { return __hip_atomic_fetch_add(p, v, __ATOMIC_RELAXED, __HIP_MEMORY_SCOPE_AGENT); }
__device__ __forceinline__ unsigned xb_xcc_id() { return (unsigned)__builtin_amdgcn_s_getreg((3 << 11) | 20) & 0xFu; }
#define XB_SPIN(cond, bar) do { unsigned _sp = 0; while (cond) { __builtin_amdgcn_s_sleep(1); \
    if ((++_sp & 255u) == 0u) { if (xb_ld(&(bar)[XB_TMO])) break; if (_sp > XB_SPIN_CAP) { atomicAdd(&(bar)[XB_TMO], 1u); break; } } } } while (0)
struct XcdBarrier { unsigned* bar; unsigned x; volatile LAS unsigned* st; };
__device__ __forceinline__ XcdBarrier xcd_barrier_post(unsigned* bar, volatile LAS unsigned* st) {
    XcdBarrier b; b.bar = bar; b.x = xb_xcc_id(); b.st = st;
    if (threadIdx.x == 0) (void)xb_add(&bar[XB_XCNT(b.x)], 1u);
    return b;
}
__device__ __forceinline__ void xcd_barrier_complete(unsigned* bar, unsigned x, unsigned& nloc, unsigned& nx) {
    const unsigned G = gridDim.x * gridDim.y * gridDim.z;
    unsigned sum, cnt, mine, sp = 0u;
    for (;;) {
        sum = 0u; cnt = 0u;
#pragma unroll 1
        for (unsigned j = 0; j < 16; ++j) { const unsigned c = xb_ld(&bar[XB_XCNT(j)]); sum += c; cnt += (c > 0u) ? 1u : 0u; }
        mine = xb_ld(&bar[XB_XCNT(x)]);
        if (sum == G) break;
        __builtin_amdgcn_s_sleep(1);
        if ((++sp & 255u) == 0u) { if (xb_ld(&bar[XB_TMO])) break; if (sp > XB_SPIN_CAP) { atomicAdd(&bar[XB_TMO], 1u); break; } }
    }
    nloc = mine > 0u ? mine : 1u; nx = cnt > 0u ? cnt : 1u;
}
__device__ __forceinline__ void xcd_barrier(const XcdBarrier& b) {
    asm volatile("s_waitcnt vmcnt(0)" ::: "memory");
    __syncthreads();
    if (threadIdx.x == 0) {
        unsigned* bar = opqp(b.bar); const unsigned bx_ = (unsigned)opq((int)xb_xcc_id());
        __builtin_amdgcn_s_waitcnt(0);
        unsigned nloc = b.st[0], nx = b.st[1];
        if (nloc == 0u) { xcd_barrier_complete(bar, bx_, nloc, nx); b.st[0] = nloc; b.st[1] = nx; }
        const unsigned old = xb_add(&bar[XB_XSUB(bx_)], 1u);
        const unsigned gen = old / nloc;
        if (old + 1u == (gen + 1u) * nloc) {
            __builtin_amdgcn_fence(__ATOMIC_RELEASE, "agent");
            asm volatile("s_waitcnt vmcnt(0)" ::: "memory");
            const unsigned og = xb_add(&bar[XB_TOP], 1u);
            const unsigned tg = og / nx;
            if (og + 1u == (tg + 1u) * nx) xb_add(&bar[XB_TOPGEN], 1u);
            else XB_SPIN(xb_ld(&bar[XB_TOPGEN]) == tg, bar);
            __builtin_amdgcn_fence(__ATOMIC_ACQUIRE, "agent");
            xb_add(&bar[XB_XGEN(bx_)], 1u);
            asm volatile("s_waitcnt vmcnt(0)" ::: "memory");
        } else {
            XB_SPIN(xb_ld(&bar[XB_XGEN(bx_)]) == gen, bar);
            __builtin_amdgcn_fence(__ATOMIC_ACQUIRE, "agent");
            asm volatile("s_waitcnt vmcnt(0)" ::: "memory");
        }
    }
    __syncthreads();
}

constexpr size_t MiB = 1u << 20;
constexpr size_t WS_CTL = 0, CTL_ZERO_BYTES = 1 * MiB;
constexpr size_t WS_MOD = 1 * MiB;
constexpr size_t WS_BZ = 1 * MiB + 512 * 1024;
constexpr size_t WS_BQZ = WS_BZ + 65536, WS_BKV = WS_BQZ + 65536;
constexpr size_t WS_SSQ = 2 * MiB;
constexpr size_t WS_W1A = 4 * MiB;
constexpr size_t WS_W2A = 68 * MiB;
constexpr size_t WS_WKV = 76 * MiB;
constexpr size_t WS_W1B = 78 * MiB;
constexpr size_t WS_W2B = 110 * MiB;
constexpr size_t WS_WUB = 114 * MiB;
constexpr size_t WS_WGT = 122 * MiB;
constexpr size_t WS_K = 126 * MiB;
constexpr size_t WS_VT = 134 * MiB;
constexpr size_t WS_TAIL = 142 * MiB, WS_HEADY = 158 * MiB, WS_HEADZ = 174 * MiB;
constexpr size_t WS_XB = 190 * MiB;
constexpr size_t WS_V = 254 * MiB;
constexpr size_t WS_AO = 382 * MiB;
constexpr size_t WS_END = 446 * MiB;
constexpr int CW_TMO = 0, CW_BAR = 4096;
constexpr int MAX_LAUNCHES = 8;
static_assert((CW_BAR + MAX_LAUNCHES * XCD_BAR_WORDS) * 4 <= (int)CTL_ZERO_BYTES, "ctl");
constexpr int RING_BYTES = 131072, LDSX_OFF = RING_BYTES, LDSX_BYTES = 24576, MISC_OFF = LDSX_OFF + LDSX_BYTES, LDS_BYTES = 163840;
constexpr int NWAVES = 8;
constexpr float QSCALE = 0.125f * 1.4426950408889634f;

struct Args { const float* in[18]; float* out; unsigned char* ws; int ph_lo, ph_hi, li, pad; };

struct Frame {
    LAS unsigned char* lds; LAS unsigned char* ldsx;
    int tid, lane, wave;
};
constexpr int GRID = 256;
__device__ __forceinline__ int vcu_of(int bx) { return (bx & 7) * (GRID / 8) + (bx >> 3); }

using pg8::Unit;
struct StaticOrder {
    int nM, nN, nwg, G, c; const char* A; const char* B; size_t tA, tB;
    __device__ void init(int M, int N, int G_, int c_, const void* A_, const void* B_, int lda, int ldb) { nM = M / 256; nN = N / 256; nwg = nM * nN; G = G_; c = c_; A = (const char*)A_; B = (const char*)B_; tA = (size_t)256 * lda * 2; tB = (size_t)256 * ldb * 2; }
    __device__ __forceinline__ bool map(long L, Unit& u) const {
        if (L >= nwg) return false;
        int wgid = (int)L; { const int q = nwg / 8, r = nwg % 8, xcd = wgid % 8, off = wgid / 8; wgid = (xcd < r ? xcd * (q + 1) : r * (q + 1) + (xcd - r) * q) + off; }
        const int nig = 8 * nN, gid = wgid / nig, fm = gid * 8, gsz = (nM - fm) < 8 ? (nM - fm) : 8;
        u.pm = fm + ((wgid % nig) % gsz); u.pn = (wgid % nig) / gsz; u.gi = 0; return true;
    }
    __device__ __forceinline__ bool next(int i, Unit& u) const { return map((long)i * G + c, u); }
    __device__ __forceinline__ void ab(const Unit& u, const char*& a, const char*& b) const { a = A + (size_t)u.pm * tA; b = B + (size_t)u.pn * tB; }
};
struct SchedA {
    int q, pn; const char* A; const char* B;
    __device__ void init(int c, const void* A_, const void* B_) { const int x = c & 7, y = c >> 3; q = 4 * (x >> 1) + (y & 3); pn = 8 * (x & 1) + (y >> 2); A = (const char*)A_; B = (const char*)B_; }
    __device__ __forceinline__ bool next(int i, Unit& u) const { if (i >= 8) return false; u.pm = 8 * q + i; u.pn = pn; u.gi = 0; return true; }
    __device__ __forceinline__ void ab(const Unit& u, const char*& a, const char*& b) const { a = A + (size_t)u.pm * (256 * 1024 * 2); b = B + ((size_t)(u.pm >> 5) * 4096 + (size_t)u.pn * 256) * (1024 * 2); }
};
struct SchedB {
    StaticOrder so; bool with_kv; const char* B2;
    __device__ __forceinline__ bool next(int i, Unit& u) const {
        const long L = (long)i * so.G + so.c;
        if (L < so.nwg) return so.map(L, u);
        if (!with_kv || L >= so.nwg + 128) return false;
        u.pm = (int)(L - so.nwg); u.pn = 0; u.gi = 1; return true;
    }
    __device__ __forceinline__ void ab(const Unit& u, const char*& a, const char*& b) const {
        a = so.A + (size_t)u.pm * (256 * 1024 * 2);
        if (u.gi == 0) b = so.B + ((size_t)(u.pm >> 5) * 2048 + (size_t)u.pn * 256) * (1024 * 2); else b = B2 + (size_t)(u.pm >> 5) * (256 * 1024 * 2);
    }
};
struct SchedW {
    int c; const char* WgT; const char* WuB;
    __device__ __forceinline__ bool next(int i, Unit& u) const { if (i > 0 || c >= 64) return false; u.pm = (c >> 2) & 1; u.pn = c & 3; u.gi = c >> 3; return true; }
    __device__ __forceinline__ void ab(const Unit& u, const char*& a, const char*& b) const {
        const int l = u.gi >> 2, g = u.gi & 3;
        a = WgT + ((size_t)(l * 4 + g) * 512 * 512 + (size_t)u.pm * 256 * 512) * 2;
        b = WuB + ((size_t)l * 1024 * 2048 + (size_t)u.pn * 256 * 2048 + (size_t)g * 512) * 2;
    }
};

using pg8::cvt_pk_bf16;
typedef unsigned u32x4 __attribute__((ext_vector_type(4)));
typedef unsigned u32x2 __attribute__((ext_vector_type(2)));
__device__ __forceinline__ u32x4 pack8(const f32x4& v0, const f32x4& v1) { u32x4 w; w.x = cvt_pk_bf16(v0[0], v0[1]); w.y = cvt_pk_bf16(v0[2], v0[3]); w.z = cvt_pk_bf16(v1[0], v1[1]); w.w = cvt_pk_bf16(v1[2], v1[3]); return w; }
constexpr int PART_OFF = 20480;
__device__ __forceinline__ void rstd_put(const float* SSQ, int pm, int tid, LAS unsigned char* ldsx) {
    const float* sp_ = SSQ + ((size_t)pm * 256 + (tid >> 1)) * 16 + 8 * (tid & 1); const f32x4 q0 = *(const f32x4*)sp_, q1 = *(const f32x4*)(sp_ + 4);
    ((LAS float*)(ldsx + PART_OFF))[tid] = ((q0[0] + q0[1]) + (q0[2] + q0[3])) + ((q1[0] + q1[1]) + (q1[2] + q1[3]));
}
__device__ __forceinline__ float rstd_get(int r, LAS unsigned char* ldsx) { const pg8::f32x2 p = *(const LAS pg8::f32x2*)(ldsx + PART_OFF + r * 8); return rsqrtf((p[0] + p[1]) * (1.f / 1024.f) + EPS); }
struct EpiWeff {
    static constexpr bool PERM = true;
    bf16* W1A; const float* a_scale; const float* norm_g; const float* mod;
    __device__ __forceinline__ void operator()(f32x4 (&acc)[2][2][4][2], const Unit& u, int ui, int wr, int wc, int fr, int fq, int lane, LAS unsigned char* ldsx) const {
        const int l = u.gi >> 2, g = u.gi & 3, k0 = u.pn * 256 + wc * 32 + 8 * fq;
#pragma unroll 1
        for (int b = 0; b < 4; ++b) {
            f32x4 gm[2][2];
#pragma unroll
            for (int bj = 0; bj < 2; ++bj)
#pragma unroll
                for (int n = 0; n < 2; ++n) { const int k = k0 + bj * 128 + 4 * n; gm[bj][n] = *(const f32x4*)(norm_g + l * 1024 + k) * (*(const f32x4*)(mod + ((size_t)l * 4 + b) * 3072 + 1024 + k) + 1.f); }
#pragma unroll
            for (int ai = 0; ai < 2; ++ai)
#pragma unroll
                for (int m = 0; m < 4; ++m) {
                    const int jj = g * 512 + u.pm * 256 + ai * 128 + wr * 64 + m * 16 + fr;
                    const float sc = a_scale[l * 2048 + jj];
                    bf16* rowp = W1A + (((size_t)l * 4 + b) * 4096 + (size_t)(256 * (jj >> 7) + (jj & 127))) * 1024 + k0;
#pragma unroll
                    for (int bj = 0; bj < 2; ++bj) *(u32x4*)(rowp + bj * 128) = pack8(acc[ai][bj][m][0] * sc * gm[bj][0], acc[ai][bj][m][1] * sc * gm[bj][1]);
                }
        }
    }
};
struct EpiResid {
    static constexpr bool PERM = true;
    bf16* XB; float* OUT; float* SSQ; const float* gate; const float* X0;
    __device__ __forceinline__ void operator()(f32x4 (&acc)[2][2][4][2], const Unit& u, int ui, int wr, int wc, int fr, int fq, int lane, LAS unsigned char* ldsx) const {
        const int row0 = u.pm * 256 + wr * 64 + fr, col0 = u.pn * 256 + wc * 32 + 8 * fq, b = u.pm >> 5;
        f32x4 gv[2][2];
#pragma unroll
        for (int bj = 0; bj < 2; ++bj)
#pragma unroll
            for (int n = 0; n < 2; ++n) gv[bj][n] = *(const f32x4*)(gate + (size_t)b * 3072 + col0 + bj * 128 + 4 * n);
#pragma unroll
        for (int ai = 0; ai < 2; ++ai) {
            f32x4 xv[4][2][2];
            if (X0) {
#pragma unroll
                for (int m = 0; m < 4; ++m)
#pragma unroll
                    for (int bj = 0; bj < 2; ++bj) { const float* p = X0 + (size_t)(row0 + ai * 128 + m * 16) * 1024 + col0 + bj * 128; xv[m][bj][0] = *(const f32x4*)p; xv[m][bj][1] = *(const f32x4*)(p + 4); }
            } else {
                u32x4 xo[4][2];
#pragma unroll
                for (int m = 0; m < 4; ++m)
#pragma unroll
                    for (int bj = 0; bj < 2; ++bj) xo[m][bj] = *(const u32x4*)(XB + (size_t)(row0 + ai * 128 + m * 16) * 1024 + col0 + bj * 128);
#pragma unroll
                for (int m = 0; m < 4; ++m)
#pragma unroll
                    for (int bj = 0; bj < 2; ++bj) { const u32x4 o = xo[m][bj];
                        xv[m][bj][0] = (f32x4){__uint_as_float(o.x << 16), __uint_as_float(o.x & 0xffff0000u), __uint_as_float(o.y << 16), __uint_as_float(o.y & 0xffff0000u)};
                        xv[m][bj][1] = (f32x4){__uint_as_float(o.z << 16), __uint_as_float(o.z & 0xffff0000u), __uint_as_float(o.w << 16), __uint_as_float(o.w & 0xffff0000u)}; }
            }
#pragma unroll
            for (int m = 0; m < 4; ++m) { const int row = row0 + ai * 128 + m * 16; const size_t off = (size_t)row * 1024 + col0;
                float ss = 0.f;
#pragma unroll
                for (int bj = 0; bj < 2; ++bj) {
                    const f32x4 y0 = xv[m][bj][0] + gv[bj][0] * acc[ai][bj][m][0], y1 = xv[m][bj][1] + gv[bj][1] * acc[ai][bj][m][1];
                    ss += (y0[0] * y0[0] + y0[1] * y0[1]) + (y0[2] * y0[2] + y0[3] * y0[3]) + (y1[0] * y1[0] + y1[1] * y1[1]) + (y1[2] * y1[2] + y1[3] * y1[3]);
                    if (OUT) { *(f32x4*)(OUT + off + bj * 128) = y0; *(f32x4*)(OUT + off + bj * 128 + 4) = y1; }
                    else *(u32x4*)(XB + off + bj * 128) = pack8(y0, y1); }
                ss += bperm_xor(ss, lane, 16); ss += bperm_xor(ss, lane, 32);
                if (fq == 0) SSQ[(size_t)row * 16 + u.pn * 4 + wc] = ss; }
            asm volatile("" ::: "memory");
        }
    }
};
struct EpiQZKV {
    static constexpr bool PERM = true;
    bf16* Q; bf16* ZS; bf16* Kb; bf16* Vt; const float* SSQ; const float* bqz; const float* bkv;
    __device__ __forceinline__ void operator()(f32x4 (&acc)[2][2][4][2], const Unit& u, int ui, int wr, int wc, int fr, int fq, int lane, LAS unsigned char* ldsx) const {
        const int row0 = u.pm * 256 + wr * 64 + fr, b = u.pm >> 5;
        rstd_put(SSQ, u.pm, (wr * 4 + wc) * 64 + lane, ldsx);
        asm volatile("s_waitcnt lgkmcnt(0)" ::: "memory"); __builtin_amdgcn_s_barrier(); asm volatile("" ::: "memory");
        float rs[2][4];
#pragma unroll
        for (int ai = 0; ai < 2; ++ai)
#pragma unroll
            for (int m = 0; m < 4; ++m) rs[ai][m] = rstd_get(ai * 128 + wr * 64 + m * 16 + fr, ldsx);
        if (u.gi == 0) {
            const bool isq = u.pn < 4; bf16* base = isq ? Q : ZS; const int col0 = (u.pn & 3) * 256 + wc * 32 + 8 * fq;
            f32x4 bv[2][2];
#pragma unroll
            for (int bj = 0; bj < 2; ++bj)
#pragma unroll
                for (int n = 0; n < 2; ++n) bv[bj][n] = *(const f32x4*)(bqz + (size_t)b * 2048 + u.pn * 256 + bj * 128 + wc * 32 + 8 * fq + 4 * n);
#pragma unroll
            for (int ai = 0; ai < 2; ++ai)
#pragma unroll
                for (int m = 0; m < 4; ++m) { bf16* rowp = base + (size_t)(row0 + ai * 128 + m * 16) * 1024 + col0;
#pragma unroll
                    for (int bj = 0; bj < 2; ++bj) { f32x4 v0 = acc[ai][bj][m][0] * rs[ai][m] + bv[bj][0], v1 = acc[ai][bj][m][1] * rs[ai][m] + bv[bj][1];
                        if (isq) { v0 = v0 * QSCALE; v1 = v1 * QSCALE; }
                        else { v0 = (f32x4){fsilu(v0[0]), fsilu(v0[1]), fsilu(v0[2]), fsilu(v0[3])}; v1 = (f32x4){fsilu(v1[0]), fsilu(v1[1]), fsilu(v1[2]), fsilu(v1[3])}; }
                        *(u32x4*)(rowp + bj * 128) = pack8(v0, v1); } }
        } else {
            const int c0 = wc * 32 + 8 * fq;
            f32x4 bv[2][2];
#pragma unroll
            for (int bj = 0; bj < 2; ++bj)
#pragma unroll
                for (int n = 0; n < 2; ++n) bv[bj][n] = *(const f32x4*)(bkv + (size_t)b * 256 + bj * 128 + c0 + 4 * n);
#pragma unroll
            for (int ai = 0; ai < 2; ++ai)
#pragma unroll
                for (int m = 0; m < 4; ++m) { const int row = row0 + ai * 128 + m * 16, t = row & (S - 1);
                    *(u32x4*)(Kb + (size_t)row * 128 + c0) = pack8(acc[ai][0][m][0] * rs[ai][m] + bv[0][0], acc[ai][0][m][1] * rs[ai][m] + bv[0][1]);
#pragma unroll
                    for (int n = 0; n < 2; ++n) { const f32x4 vv = acc[ai][1][m][n] * rs[ai][m] + bv[1][n];
#pragma unroll
                        for (int i = 0; i < 4; ++i) { const int v = c0 + 4 * n + i, kvh = v >> 6, d = v & 63;
                            Vt[((size_t)((b * 2 + kvh) * 64 + d)) * S + t] = (bf16)f2bf(vv[i]); } }
                }
        }
    }
};

template <int CTRL> __device__ __forceinline__ float dppz(float v) { return __builtin_bit_cast(float, __builtin_amdgcn_update_dpp(0, __builtin_bit_cast(int, v), CTRL, 0xf, 0xf, true)); }
template <int N> __device__ __forceinline__ float row_shr0(float v) { return dppz<0x110 + N>(v); }
template <int N> __device__ __forceinline__ float row_shl0(float v) { return dppz<0x100 + N>(v); }
template <int Dd> __device__ __forceinline__ void dbl_step(f32x4 (&s)[5]) {
#pragma unroll
    for (int m = 4; m >= 1; --m)
#pragma unroll
        for (int i = 0; i < 4; ++i) s[m][i] = s[m][i] + row_shr0<Dd>(s[m][i]) + row_shl0<16 - Dd>(s[m - 1][i]);
#pragma unroll
    for (int i = 0; i < 4; ++i) s[0][i] = s[0][i] + row_shr0<Dd>(s[0][i]);
}
struct EpiPool {
    static constexpr bool PERM = true;
    bf16* V; float* TAIL; float* HEADY; float* HEADZ; const float* SSQ; const float* bz;
    template <int GI> __device__ __forceinline__ void pool_blocks(f32x4 (&s)[5]) const {
        dbl_step<1>(s);
        if constexpr (GI >= 1) dbl_step<2>(s);
        if constexpr (GI >= 2) dbl_step<4>(s);
        if constexpr (GI >= 3) dbl_step<8>(s);
    }
    __device__ __forceinline__ void operator()(f32x4 (&acc)[2][2][4][2], const Unit& u, int ui, int wr, int wc, int fr, int fq, int lane, LAS unsigned char* ldsx) const {
        const int g = u.pn >> 2;
        if (g == 0) run<0>(acc, u, ui, wr, wc, fr, fq, lane, ldsx); else if (g == 1) run<1>(acc, u, ui, wr, wc, fr, fq, lane, ldsx);
        else if (g == 2) run<2>(acc, u, ui, wr, wc, fr, fq, lane, ldsx); else run<3>(acc, u, ui, wr, wc, fr, fq, lane, ldsx);
    }
    template <int GI> __device__ __forceinline__ void run(f32x4 (&acc)[2][2][4][2], const Unit& u, int ui, int wr, int wc, int fr, int fq, int lane, LAS unsigned char* ldsx) const {
        constexpr int g = GI, w = 2 << g; const int t0 = (u.pm & 31) * 256, b = u.pm >> 5;
        const bool first = (ui == 0), lastu = (ui == 7), seq0 = (t0 == 0);
        const int colg = u.pn * 128 + wc * 32 + 8 * fq;
        const int carry_in = 3 + (ui & 1), carry_out = 3 + ((ui + 1) & 1);
        rstd_put(SSQ, u.pm, (wr * 4 + wc) * 64 + lane, ldsx);
#pragma unroll
        for (int ai = 0; ai < 2; ++ai) { const int ch = 2 * ai + wr; if (ch < 3) *(LAS u32x4*)(ldsx + ch * 4096 + wc * 1024 + lane * 16) = pack8(acc[ai][0][3][0], acc[ai][0][3][1]); }
        asm volatile("s_waitcnt lgkmcnt(0)" ::: "memory"); __builtin_amdgcn_s_barrier(); asm volatile("" ::: "memory");
        const float invw = 1.f / (float)w;
#pragma unroll
        for (int ai = 0; ai < 2; ++ai) {
            const int ch = 2 * ai + wr; const bool havep = (ch > 0) || (!seq0 && !first);
            u32x4 pw = (u32x4){0u, 0u, 0u, 0u};
            if (havep) pw = *(const LAS u32x4*)(ldsx + (ch > 0 ? ch - 1 : carry_in) * 4096 + wc * 1024 + lane * 16);
            const float rsp = ch > 0 ? rstd_get(64 * (ch - 1) + 48 + fr, ldsx) : 1.f;
            float rs[4];
#pragma unroll
            for (int m = 0; m < 4; ++m) rs[m] = rstd_get(ai * 128 + wr * 64 + m * 16 + fr, ldsx);
            u32x2 pk[4][2];
#pragma unroll
            for (int n = 0; n < 2; ++n) {
                f32x4 s[5], yo[4];
                const unsigned p0 = n == 0 ? pw.x : pw.z, p1 = n == 0 ? pw.y : pw.w;
                s[0] = (f32x4){__builtin_bit_cast(float, p0 << 16), __builtin_bit_cast(float, p0 & 0xffff0000u), __builtin_bit_cast(float, p1 << 16), __builtin_bit_cast(float, p1 & 0xffff0000u)} * rsp;
#pragma unroll
                for (int m = 0; m < 4; ++m) { s[m + 1] = acc[ai][0][m][n] * rs[m]; yo[m] = s[m + 1]; }
                if (ch == 3) { u32x2 cw; cw.x = cvt_pk_bf16(yo[3][0], yo[3][1]); cw.y = cvt_pk_bf16(yo[3][2], yo[3][3]); *(LAS u32x2*)(ldsx + carry_out * 4096 + wc * 1024 + lane * 16 + n * 8) = cw;
                    if (lastu) *(f32x4*)(TAIL + ((size_t)u.pm * 16 + fr) * 2048 + colg + 4 * n) = yo[3]; }
                if (ch == 0 && first && !seq0) *(f32x4*)(HEADY + ((size_t)u.pm * 16 + fr) * 2048 + colg + 4 * n) = yo[0];
                pool_blocks<GI>(s);
                const f32x4 bzv = *(const f32x4*)(bz + (size_t)b * 2048 + colg + 4 * n);
#pragma unroll
                for (int m = 0; m < 4; ++m) {
                    float inv = invw; if (seq0 && ch == 0 && m == 0 && fr < w - 1) inv = 1.f / (float)(fr + 1);
                    const f32x4 z = acc[ai][1][m][n] * rs[m] + bzv, p = s[m + 1] * inv - yo[m];
                    const f32x4 sz = (f32x4){fsilu(z[0]), fsilu(z[1]), fsilu(z[2]), fsilu(z[3])};
                    if (ch == 0 && m == 0 && first && !seq0) *(f32x4*)(HEADZ + ((size_t)u.pm * 16 + fr) * 2048 + colg + 4 * n) = sz;
                    const f32x4 o = p * sz;
                    pk[m][n].x = cvt_pk_bf16(o[0], o[1]); pk[m][n].y = cvt_pk_bf16(o[2], o[3]);
                }
            }
#pragma unroll
            for (int m = 0; m < 4; ++m) { const int row = u.pm * 256 + ai * 128 + wr * 64 + m * 16 + fr;
                *(u32x4*)(V + (size_t)row * 2048 + colg) = (u32x4){pk[m][0].x, pk[m][0].y, pk[m][1].x, pk[m][1].y}; }
        }
    }
};
__device__ __forceinline__ void tr_item(const float* src, int sp, bf16* dst, int dp, LAS float* scr, int lane) {
#pragma unroll
    for (int i = 0; i < 32; ++i) { const int kk = 2 * i + (lane >> 5); scr[kk * 33 + (lane & 31)] = src[(size_t)kk * sp + (lane & 31)]; }
    LDS_WAIT(); asm volatile("" ::: "memory");
    const int c = lane & 7;
#pragma unroll
    for (int j = 0; j < 4; ++j) { const int n = (lane >> 3) + 8 * j; const LAS float* s = scr + (8 * c) * 33 + n;
        v4u o; o.x = pk2(s[0 * 33], s[1 * 33]); o.y = pk2(s[2 * 33], s[3 * 33]); o.z = pk2(s[4 * 33], s[5 * 33]); o.w = pk2(s[6 * 33], s[7 * 33]);
        *(v4u*)(dst + (size_t)n * dp + 8 * c) = o; }
    LDS_WAIT(); asm volatile("" ::: "memory");
}
struct PT {
    volatile LAS unsigned* tab;
    __device__ __forceinline__ unsigned long long raw(int i) const { const unsigned lo = __builtin_amdgcn_readfirstlane(tab[2 * i]), hi = __builtin_amdgcn_readfirstlane(tab[2 * i + 1]); return ((unsigned long long)hi << 32) | lo; }
    __device__ __forceinline__ const float* in(int i) const { return (const float*)raw(i); }
    __device__ __forceinline__ float* out() const { return (float*)raw(18); }
    __device__ __forceinline__ unsigned char* ws() const { return (unsigned char*)raw(19); }
    __device__ __forceinline__ bf16* wsb(size_t off) const { return (bf16*)(ws() + off); }
    __device__ __forceinline__ float* wsf(size_t off) const { return (float*)(ws() + off); }
};
enum { I_X = 0, I_C, I_NORMG, I_ADAW, I_ADAB, I_AWIN, I_AWG, I_ASCALE, I_AWOUT, I_KVNG, I_KVADAW, I_KVADAB, I_WKV, I_BWIN, I_SINKS, I_BWOUT, I_RELB, I_FINALG };
__device__ __forceinline__ void gemv64(const Frame& F, const LAS float* vec, LAS float* red, const float* W, int pitch, int n, const float* bias, float* out, int opitch) {
    float a0 = 0.f, a1 = 0.f, a2 = 0.f, a3 = 0.f;
    const int kb = F.wave * 128;
#pragma unroll 32
    for (int k = 0; k < 128; ++k) { const float wv = W[(size_t)(kb + k) * pitch + n]; const f32x4 cv = *(const LAS f32x4*)(vec + (kb + k) * 4);
        a0 += cv[0] * wv; a1 += cv[1] * wv; a2 += cv[2] * wv; a3 += cv[3] * wv; }
    red[(F.wave * 4 + 0) * 64 + F.lane] = a0; red[(F.wave * 4 + 1) * 64 + F.lane] = a1; red[(F.wave * 4 + 2) * 64 + F.lane] = a2; red[(F.wave * 4 + 3) * 64 + F.lane] = a3;
    __syncthreads();
    if (F.tid < 256) { const int b = F.tid >> 6, cl = F.tid & 63; float s = 0.f;
#pragma unroll
        for (int w = 0; w < 8; ++w) s += red[(w * 4 + b) * 64 + cl];
        out[(size_t)b * opitch + n] = s + (bias ? bias[n] : 0.f); }
    __syncthreads();
}
__device__ __forceinline__ void p0a_prologue(const Frame& F0, const PT& P) {
    Frame F = F0; F.lane = lane_id_v(); F.tid = F.wave * 64 + F.lane;
    LAS float* vec = (LAS float*)(F.lds + 98304);
    LAS float* red = (LAS float*)(F.lds + 114688);
    const int bx0 = opq((int)blockIdx.x);
    if (bx0 < 224) {
        const float* cc = P.in(I_C);
        for (int i = F.tid; i < 4096; i += 512) { const int b = i >> 10, k = i & 1023; const float cv = cc[b * 1024 + k]; vec[k * 4 + b] = cv / (1.f + expf(-cv)); }
        __syncthreads();
        const int gid = bx0 * 64 + F.lane;
        if (gid < 12288) { const int l = gid / 3072, n = gid % 3072; gemv64(F, vec, red, P.in(I_ADAW) + (size_t)l * 1024 * 3072, 3072, n, P.in(I_ADAB) + l * 3072, P.wsf(WS_MOD) + (size_t)l * 4 * 3072, 3072); }
        else { const int n = gid - 12288; gemv64(F, vec, red, P.in(I_KVADAW), 2048, n, P.in(I_KVADAB), P.wsf(WS_MOD) + 4 * 4 * 3072, 2048); }
    }
    LAS float* scr = (LAS float*)(F.lds + F.wave * 8448);
    const int gw = vcu_of(bx0) * NWAVES + F.wave, NGW = GRID * NWAVES;
    constexpr int J1 = 2048, J4 = 1024, J5 = 1024, J6 = 2048;
    for (int it = gw; it < J1 + J4 + J5 + J6; it += NGW) {
        int r = it;
        if (r < J1) { const int l = r >> 10, q = r & 1023, kbk = q >> 5, nb = q & 31, k0 = kbk * 64, n0 = nb * 32;
            tr_item(P.in(I_AWOUT) + (size_t)l * 2048 * 1024 + (size_t)k0 * 1024 + n0, 1024, P.wsb(WS_W2A) + ((size_t)l * 1024 + n0) * 2048 + k0, 2048, scr, F.lane); continue; } r -= J1;
        if (r < J4) { const int l = r >> 9, q = r & 511, kbk = q >> 5, nb = q & 31, k0 = kbk * 64, n0 = nb * 32;
            tr_item(P.in(I_BWOUT) + (size_t)l * 1024 * 1024 + (size_t)k0 * 1024 + n0, 1024, P.wsb(WS_W2B) + ((size_t)l * 1024 + n0) * 1024 + k0, 1024, scr, F.lane); continue; } r -= J4;
        if (r < J5) { const int lg = r >> 7, q = r & 127, kbk = q >> 4, nb = q & 15, k0 = kbk * 64, n0 = nb * 32;
            tr_item(P.in(I_AWG) + (size_t)lg * 512 * 512 + (size_t)k0 * 512 + n0, 512, P.wsb(WS_WGT) + ((size_t)lg * 512 + n0) * 512 + k0, 512, scr, F.lane); continue; } r -= J5;
        { const int l = r >> 10, k = r & 1023; const float* src = P.in(I_AWIN) + (size_t)l * 1024 * 4096 + (size_t)k * 4096; bf16* dst = P.wsb(WS_WUB) + ((size_t)l * 1024 + k) * 2048;
#pragma unroll
          for (int p = 0; p < 4; ++p) { const int c0 = p * 512 + F.lane * 8; const f32x4 a = *(const f32x4*)(src + c0), b = *(const f32x4*)(src + c0 + 4);
              v4u o; o.x = pk2(a[0], a[1]); o.y = pk2(a[2], a[3]); o.z = pk2(b[0], b[1]); o.w = pk2(b[2], b[3]); *(v4u*)(dst + c0) = o; } }
    }
    { const float* X = P.in(I_X); bf16* XB = P.wsb(WS_XB); float* SSQ = P.wsf(WS_SSQ);
      f32x4 v[4], vn[4]; int row = gw;
#pragma unroll
      for (int j = 0; j < 4; ++j) vn[j] = *((const f32x4*)(X + (size_t)row * D) + F.lane + 64 * j);
      for (; row < T; row += NGW) {
#pragma unroll
          for (int j = 0; j < 4; ++j) v[j] = vn[j];
          const int nr = row + NGW;
          if (nr < T) {
#pragma unroll
              for (int j = 0; j < 4; ++j) vn[j] = *((const f32x4*)(X + (size_t)nr * D) + F.lane + 64 * j); }
          float s = 0.f;
#pragma unroll
          for (int j = 0; j < 4; ++j) { s += (v[j][0] * v[j][0] + v[j][1] * v[j][1]) + (v[j][2] * v[j][2] + v[j][3] * v[j][3]);
              u32x2 w; w.x = pk2(v[j][0], v[j][1]); w.y = pk2(v[j][2], v[j][3]); *(u32x2*)(XB + (size_t)row * D + (F.lane + 64 * j) * 4) = w; }
          s = wave_sum(s, F.lane);
          if (F.lane < 16) SSQ[(size_t)row * 16 + F.lane] = (F.lane == 0) ? s : 0.f;
      } }
}
__device__ __forceinline__ void tr_item_fold(const float* src, int sp, bf16* dst, int dp, size_t dbs, const float* g, const float* sc, int scb, LAS float* scr, int lane) {
#pragma unroll
    for (int i = 0; i < 32; ++i) { const int kk = 2 * i + (lane >> 5); scr[kk * 33 + (lane & 31)] = src[(size_t)kk * sp + (lane & 31)]; }
    LDS_WAIT(); asm volatile("" ::: "memory");
    const int c = lane & 7;
    const f32x4 g0 = *(const f32x4*)(g + 8 * c), g1 = *(const f32x4*)(g + 8 * c + 4);
#pragma unroll 1
    for (int b = 0; b < 4; ++b) {
        const f32x4 m0 = g0 * (*(const f32x4*)(sc + (size_t)b * scb + 8 * c) + 1.f), m1 = g1 * (*(const f32x4*)(sc + (size_t)b * scb + 8 * c + 4) + 1.f);
#pragma unroll
        for (int j = 0; j < 4; ++j) { const int n = (lane >> 3) + 8 * j; const LAS float* s = scr + (8 * c) * 33 + n;
            v4u o; o.x = pk2(s[0 * 33] * m0[0], s[1 * 33] * m0[1]); o.y = pk2(s[2 * 33] * m0[2], s[3 * 33] * m0[3]); o.z = pk2(s[4 * 33] * m1[0], s[5 * 33] * m1[1]); o.w = pk2(s[6 * 33] * m1[2], s[7 * 33] * m1[3]);
            *(v4u*)(dst + (size_t)b * dbs + (size_t)n * dp + 8 * c) = o; }
    }
    LDS_WAIT(); asm volatile("" ::: "memory");
}
__device__ __forceinline__ void p0b_prologue(const Frame& F0, const PT& P) {
    Frame F = F0; F.lane = lane_id_v(); F.tid = F.wave * 64 + F.lane;
    LAS float* vec = (LAS float*)(F.lds + 98304);
    LAS float* red = (LAS float*)(F.lds + 114688);
    const int bx0 = opq((int)blockIdx.x);
    if (bx0 >= 64 && bx0 < 196) {
        const int it = bx0 - 64;
        const float* shift; int spitch; const float* W; int pitch, n; float* out; int opitch;
        if (it < 64) { const int l = it >> 5; n = (it & 31) * 64 + F.lane; shift = P.wsf(WS_MOD) + (size_t)l * 4 * 3072; spitch = 3072; W = P.in(I_AWIN) + (size_t)l * 1024 * 4096 + 2048; pitch = 4096; out = P.wsf(WS_BZ) + (size_t)l * 4 * 2048; opitch = 2048; }
        else if (it < 128) { const int j = (it - 64) >> 5; n = (it & 31) * 64 + F.lane; shift = P.wsf(WS_MOD) + (size_t)(2 + j) * 4 * 3072; spitch = 3072; W = P.in(I_BWIN) + (size_t)j * 1024 * 2048; pitch = 2048; out = P.wsf(WS_BQZ) + (size_t)j * 4 * 2048; opitch = 2048; }
        else { n = (it - 128) * 64 + F.lane; shift = P.wsf(WS_MOD) + 4 * 4 * 3072; spitch = 2048; W = P.in(I_WKV); pitch = 256; out = P.wsf(WS_BKV); opitch = 256; }
        for (int i = F.tid; i < 4096; i += 512) { const int b = i >> 10, k = i & 1023; vec[k * 4 + b] = shift[(size_t)b * spitch + k]; }
        __syncthreads();
        gemv64(F, vec, red, W, pitch, n, nullptr, out, opitch);
    }
    LAS float* scr = (LAS float*)(F.lds + F.wave * 8448);
    const int gw = vcu_of(bx0) * NWAVES + F.wave, NGW = GRID * NWAVES;
    constexpr int F0n = 2048, F1n = 2048, F2n = 128;
    for (int it = gw; it < F0n + F1n + F2n; it += NGW) {
        int r = it;
        if (r < F0n) { const int l = r >> 10, q = r & 1023, kbk = q >> 6, nb = q & 63, k0 = kbk * 64, n0 = nb * 32;
            tr_item_fold(P.in(I_AWIN) + (size_t)l * 1024 * 4096 + (size_t)k0 * 4096 + 2048 + n0, 4096,
                         P.wsb(WS_W1A) + ((size_t)l * 4 * 4096 + 256 * (n0 >> 7) + 128 + (n0 & 127)) * 1024 + k0, 1024, (size_t)4096 * 1024,
                         P.in(I_NORMG) + l * 1024 + k0, P.wsf(WS_MOD) + (size_t)l * 4 * 3072 + 1024 + k0, 3072, scr, F.lane); continue; } r -= F0n;
        if (r < F1n) { const int j = r >> 10, q = r & 1023, kbk = q >> 6, nb = q & 63, k0 = kbk * 64, n0 = nb * 32;
            tr_item_fold(P.in(I_BWIN) + (size_t)j * 1024 * 2048 + (size_t)k0 * 2048 + n0, 2048,
                         P.wsb(WS_W1B) + ((size_t)j * 4 * 2048 + n0) * 1024 + k0, 1024, (size_t)2048 * 1024,
                         P.in(I_NORMG) + (2 + j) * 1024 + k0, P.wsf(WS_MOD) + (size_t)(2 + j) * 4 * 3072 + 1024 + k0, 3072, scr, F.lane); continue; } r -= F1n;
        { const int kbk = r >> 3, nb = r & 7, k0 = kbk * 64, n0 = nb * 32;
            tr_item_fold(P.in(I_WKV) + (size_t)k0 * 256 + n0, 256, P.wsb(WS_WKV) + (size_t)n0 * 1024 + k0, 1024, (size_t)256 * 1024,
                         P.in(I_KVNG) + k0, P.wsf(WS_MOD) + 4 * 4 * 3072 + 1024 + k0, 2048, scr, F.lane); }
    }
}
__device__ __forceinline__ void final_norm(const Frame& F0, float* X, const float* SSQ, const float* g) {
    Frame F = F0; F.lane = lane_id_v(); F.tid = F.wave * 64 + F.lane;
    const int gw = vcu_of(opq((int)blockIdx.x)) * NWAVES + F.wave, NGW = GRID * NWAVES;
    for (int row = gw; row < T; row += NGW) {
        f32x4 v[4];
#pragma unroll
        for (int j = 0; j < 4; ++j) v[j] = *((const f32x4*)(X + (size_t)row * D) + F.lane + 64 * j);
        float s = (F.lane < 16) ? SSQ[(size_t)row * 16 + F.lane] : 0.f;
        const float rstd = rsqrtf(wave_sum(s, F.lane) * (1.f / D) + EPS);
#pragma unroll
        for (int j = 0; j < 4; ++j) { const int k = (F.lane + 64 * j) * 4; const f32x4 gg = *(const f32x4*)(g + k); *((f32x4*)(X + (size_t)row * D) + F.lane + 64 * j) = v[j] * rstd * gg; }
    }
}
__device__ __forceinline__ void pool_fixup(const Frame& F0, const PT& P) {
    Frame F = F0; F.lane = lane_id_v(); F.tid = F.wave * 64 + F.lane;
    const float* TAIL = P.wsf(WS_TAIL); const float* HEADY = P.wsf(WS_HEADY); const float* HEADZ = P.wsf(WS_HEADZ); bf16* Vb = P.wsb(WS_V);
    const int gt = vcu_of(opq((int)blockIdx.x)) * 512 + F.tid, NT_ = GRID * 512;
    for (int it = gt; it < 12 * 2048; it += NT_) {
        const int pi = it >> 11, j = it & 2047, qq = (pi / 3) * 4 + (pi % 3) + 1, pm = 8 * qq, g = j >> 9;
        float a[32], zs[16], y0[16], win[16];
#pragma unroll
        for (int r = 0; r < 16; ++r) { a[r] = TAIL[((size_t)(pm - 1) * 16 + r) * 2048 + j]; a[16 + r] = HEADY[((size_t)pm * 16 + r) * 2048 + j]; zs[r] = HEADZ[((size_t)pm * 16 + r) * 2048 + j]; y0[r] = a[16 + r]; }
#pragma unroll
        for (int i = 31; i >= 1; --i) a[i] += a[i - 1];
#pragma unroll
        for (int r = 0; r < 16; ++r) win[r] = a[16 + r];
#pragma unroll
        for (int i = 31; i >= 2; --i) a[i] += a[i - 2];
        if (g >= 1) {
#pragma unroll
            for (int r = 0; r < 16; ++r) win[r] = a[16 + r]; }
#pragma unroll
        for (int i = 31; i >= 4; --i) a[i] += a[i - 4];
        if (g >= 2) {
#pragma unroll
            for (int r = 0; r < 16; ++r) win[r] = a[16 + r]; }
#pragma unroll
        for (int i = 31; i >= 8; --i) a[i] += a[i - 8];
        if (g >= 3) {
#pragma unroll
            for (int r = 0; r < 16; ++r) win[r] = a[16 + r]; }
        const float inv = 1.f / (float)(2 << g);
#pragma unroll
        for (int r = 0; r < 16; ++r) Vb[((size_t)pm * 256 + r) * 2048 + j] = (bf16)f2bf((win[r] * inv - y0[r]) * zs[r]);
    }
}
namespace att {
typedef short bf16x8 __attribute__((ext_vector_type(8)));
typedef short s16x4 __attribute__((ext_vector_type(4)));
typedef float f32x16 __attribute__((ext_vector_type(16)));
constexpr int KS_OFF = 0, KROW = 144, VS_OFF = 36864, VROW = 520, BT_OFF = 70144, BT_N = 192, ST_OFF = 76288, ST_ROWB = 272, ST_WAVE = 32 * ST_ROWB;
static_assert(ST_OFF + 8 * ST_WAVE <= MISC_OFF, "attention LDS map");
constexpr float L2E = 1.4426950408889634f, NEG = -1e30f;
__device__ __forceinline__ int crow(int r, int h) { return (r & 3) + 8 * (r >> 2) + 4 * h; }
__device__ __forceinline__ float xhalf_max(float v) { auto rr = __builtin_amdgcn_permlane32_swap(__float_as_uint(v), __float_as_uint(v), false, false); return fmaxf(__uint_as_float(rr[0]), __uint_as_float(rr[1])); }
__device__ __forceinline__ float xhalf_sum(float v) { auto rr = __builtin_amdgcn_permlane32_swap(__float_as_uint(v), __float_as_uint(v), false, false); return __uint_as_float(rr[0]) + __uint_as_float(rr[1]); }

__device__ __forceinline__ void attn_phase(const Frame& F0, const bf16* Q, const bf16* ZS, const bf16* Kb, const bf16* Vt, const float* sinks, const float* rel_bias, bf16* AO) {
    const int lane_ = lane_id_v();
    const int lane = lane_, wave = F0.wave, tid = wave * 64 + lane, q = lane & 31, h = lane >> 5;
    LAS unsigned char* lds = F0.lds;
    const int vcu = vcu_of(opq((int)blockIdx.x));
#pragma unroll 1
    for (int ui = 0; ui < 2; ++ui) {
        const int uid = vcu * 2 + ui, qblk = uid & 63, kvh = (uid >> 6) & 1, b = uid >> 7, t0 = qblk * 128; const bool seq0 = (qblk == 0);
        const size_t R0 = (size_t)b * S + t0;
        { v4u kv[4], vv[4];
#pragma unroll
          for (int p = 0; p < 4; ++p) { const int row = p * 64 + (tid >> 3), ch = tid & 7; kv[p] = (v4u){0u, 0u, 0u, 0u};
              if (!(seq0 && row < 128)) kv[p] = *(const v4u*)(Kb + (R0 - 128 + row) * 128 + kvh * 64 + ch * 8); }
#pragma unroll
          for (int p = 0; p < 4; ++p) { const int d = p * 16 + (tid >> 5), ch = tid & 31; vv[p] = (v4u){0u, 0u, 0u, 0u};
              if (!(seq0 && ch < 16)) vv[p] = *(const v4u*)(Vt + ((size_t)((b * 2 + kvh) * 64 + d)) * S + t0 - 128 + ch * 8); }
          for (int e = tid; e < 8 * BT_N; e += 512) { const int w = e / BT_N, n = e % BT_N - 32;
              ((LAS float*)(lds + BT_OFF))[e] = (n >= 0 && n < 128) ? rel_bias[BUCKET[n] * NH + kvh * 8 + w] * L2E : 0.f; }
#pragma unroll
          for (int p = 0; p < 4; ++p) { const int row = p * 64 + (tid >> 3), ch = tid & 7; *(LAS v4u*)(lds + KS_OFF + row * KROW + ch * 16) = kv[p]; }
#pragma unroll
          for (int p = 0; p < 4; ++p) { const int d = p * 16 + (tid >> 5), ch = tid & 31; LAS unsigned char* dst = lds + VS_OFF + d * VROW + ch * 16;
              *(LAS u32x2*)dst = (u32x2){vv[p].x, vv[p].y}; *(LAS u32x2*)(dst + 8) = (u32x2){vv[p].z, vv[p].w}; }
        }
        __syncthreads();
        const int hq = kvh * 8 + wave; const float sink2 = sinks[hq] * L2E;
        const LAS float* bt = (const LAS float*)(lds + BT_OFF) + wave * BT_N + 32 + q - 4 * h;
        LAS unsigned char* stg = lds + ST_OFF + wave * ST_WAVE;
        bf16x8 qn[4];
        { const bf16* Qr = Q + (R0 + q) * 1024 + hq * 64 + 8 * h;
#pragma unroll
          for (int s = 0; s < 4; ++s) qn[s] = *(const bf16x8*)(Qr + 16 * s); }
#pragma unroll 1
        for (int qi = 0; qi < 4; ++qi) {
            bf16x8 qf[4];
#pragma unroll
            for (int s = 0; s < 4; ++s) qf[s] = qn[s];
            if (qi < 3) { const bf16* Qr = Q + (R0 + 32 * (qi + 1) + q) * 1024 + hq * 64 + 8 * h;
#pragma unroll
                for (int s = 0; s < 4; ++s) qn[s] = *(const bf16x8*)(Qr + 16 * s); }
            v4u zz[4];
#pragma unroll
            for (int i = 0; i < 4; ++i) zz[i] = *(const v4u*)(ZS + (R0 + 32 * qi + i * 8 + (lane >> 3)) * 1024 + hq * 64 + (lane & 7) * 8);
            f32x16 p[5];
#pragma unroll
            for (int kk = 0; kk < 5; ++kk) {
                const int sb = qi + kk;
#pragma unroll
                for (int r = 0; r < 16; ++r) p[kk][r] = bt[128 - 32 * kk - ((r & 3) + 8 * (r >> 2))];
                const LAS unsigned char* kp = lds + KS_OFF + (32 * sb + q) * KROW + h * 16;
#pragma unroll
                for (int s = 0; s < 4; ++s) { const bf16x8 kf = *(const LAS bf16x8*)(kp + s * 32); p[kk] = __builtin_amdgcn_mfma_f32_32x32x16_bf16(kf, qf[s], p[kk], 0, 0, 0); }
            }
#pragma unroll
            for (int r = 0; r < 16; ++r) { const int cr = crow(r, h); if (cr <= q) p[0][r] = NEG; if (cr > q) p[4][r] = NEG; }
            if (seq0) {
#pragma unroll
                for (int kk = 0; kk < 4; ++kk) if (qi + kk < 4) {
#pragma unroll
                    for (int r = 0; r < 16; ++r) p[kk][r] = NEG; }
            }
            float m = sink2;
#pragma unroll
            for (int kk = 0; kk < 5; ++kk)
#pragma unroll
                for (int r = 0; r < 16; ++r) m = fmaxf(m, p[kk][r]);
            m = xhalf_max(m);
            float l = 0.f;
#pragma unroll
            for (int kk = 0; kk < 5; ++kk)
#pragma unroll
                for (int r = 0; r < 16; ++r) { p[kk][r] = __builtin_amdgcn_exp2f(p[kk][r] - m); l += p[kk][r]; }
            l = xhalf_sum(l) + __builtin_amdgcn_exp2f(sink2 - m);
            const float il = __builtin_amdgcn_rcpf(l);
            f32x16 o[2];
#pragma unroll
            for (int d0 = 0; d0 < 2; ++d0)
#pragma unroll
                for (int r = 0; r < 16; ++r) o[d0][r] = 0.f;
#pragma unroll
            for (int kk = 0; kk < 5; ++kk) {
                const int sb = qi + kk;
#pragma unroll
                for (int s2 = 0; s2 < 2; ++s2) {
                    u32x4 pw; pw.x = cvt_pk_bf16(p[kk][8 * s2 + 0], p[kk][8 * s2 + 1]); pw.y = cvt_pk_bf16(p[kk][8 * s2 + 2], p[kk][8 * s2 + 3]);
                    pw.z = cvt_pk_bf16(p[kk][8 * s2 + 4], p[kk][8 * s2 + 5]); pw.w = cvt_pk_bf16(p[kk][8 * s2 + 6], p[kk][8 * s2 + 7]);
                    const bf16x8 pf = __builtin_bit_cast(bf16x8, pw);
#pragma unroll
                    for (int d0 = 0; d0 < 2; ++d0) {
                        const LAS unsigned char* vp = lds + VS_OFF + (32 * d0 + q) * VROW + (32 * sb + 16 * s2 + 4 * h) * 2;
                        const s16x4 lo = *(const LAS s16x4*)vp, hi = *(const LAS s16x4*)(vp + 16);
                        const bf16x8 vf = (bf16x8){lo[0], lo[1], lo[2], lo[3], hi[0], hi[1], hi[2], hi[3]};
                        o[d0] = __builtin_amdgcn_mfma_f32_32x32x16_bf16(vf, pf, o[d0], 0, 0, 0);
                    }
                }
            }
#pragma unroll
            for (int d0 = 0; d0 < 2; ++d0)
#pragma unroll
                for (int rg = 0; rg < 4; ++rg)
                    *(LAS f32x4*)(stg + q * ST_ROWB + (32 * d0 + 8 * rg + 4 * h) * 4) = (f32x4){o[d0][4 * rg] * il, o[d0][4 * rg + 1] * il, o[d0][4 * rg + 2] * il, o[d0][4 * rg + 3] * il};
            LDS_WAIT(); asm volatile("" ::: "memory");
#pragma unroll
            for (int i = 0; i < 4; ++i) { const int row = i * 8 + (lane >> 3), ch = lane & 7; const size_t goff = (R0 + 32 * qi + row) * 1024 + hq * 64 + ch * 8;
                const v4u zzi = zz[i];
                const f32x4 a0 = *(const LAS f32x4*)(stg + row * ST_ROWB + ch * 32), a1 = *(const LAS f32x4*)(stg + row * ST_ROWB + ch * 32 + 16);
                v4u w; w.x = cvt_pk_bf16(a0[0] * __uint_as_float(zzi.x << 16), a0[1] * __uint_as_float(zzi.x & 0xffff0000u)); w.y = cvt_pk_bf16(a0[2] * __uint_as_float(zzi.y << 16), a0[3] * __uint_as_float(zzi.y & 0xffff0000u));
                w.z = cvt_pk_bf16(a1[0] * __uint_as_float(zzi.z << 16), a1[1] * __uint_as_float(zzi.z & 0xffff0000u)); w.w = cvt_pk_bf16(a1[2] * __uint_as_float(zzi.w << 16), a1[3] * __uint_as_float(zzi.w & 0xffff0000u));
                *(v4u*)(AO + goff) = w; }
            LDS_WAIT(); asm volatile("" ::: "memory");
        }
        __syncthreads();
    }
}
}
__global__ void __launch_bounds__(256) k_attn2(const bf16* Q, const bf16* ZS, const bf16* Kb, const bf16* Vt, const float* sinks, const float* rel_bias, bf16* AO) {
    const int gid = blockIdx.x * 256 + threadIdx.x, hq = gid & 15, row = gid >> 4, t = row % S, b = row / S, kvh = hq >> 3;
    float q[64], o[64];
#pragma unroll
    for (int d = 0; d < 64; ++d) { q[d] = bf2f(Q[(size_t)row * D + hq * 64 + d]); o[d] = 0.f; }
    const float L2E = 1.4426950408889634f;
    float m = sinks[hq] * L2E, l = 1.f;
    const int nk = (t + 1 < WIN) ? t + 1 : WIN;
    const bf16* vb = Vt + (size_t)((b * 2 + kvh) * 64) * S;
    for (int i = 0; i < nk; ++i) {
        const bf16* kr = Kb + (size_t)(row - i) * 128 + kvh * 64;
        float s = 0.f;
#pragma unroll
        for (int d = 0; d < 64; ++d) s += q[d] * bf2f(kr[d]);
        s += rel_bias[BUCKET[i] * NH + hq] * L2E;
        const float mn = fmaxf(m, s), corr = exp2f(m - mn), p = exp2f(s - mn);
        l = l * corr + p; m = mn;
#pragma unroll
        for (int d = 0; d < 64; ++d) o[d] = o[d] * corr + p * bf2f(vb[(size_t)d * S + (t - i)]);
    }
    const float il = 1.f / l;
#pragma unroll
    for (int d = 0; d < 64; ++d) AO[(size_t)row * D + hq * 64 + d] = (bf16)f2bf(o[d] * il * bf2f(ZS[(size_t)row * D + hq * 64 + d]));
}

#ifndef REP_SEL
#define REP_SEL 0
#endif
#define REPS(k) for (int rep_ = 0; rep_ < ((REP_SEL == (k)) ? 2 : 1); ++rep_)
__global__ void __launch_bounds__(NWAVES * 64, 2) mk_fwd(Args args) {
    extern __shared__ __attribute__((aligned(16))) unsigned char lds_raw[];
    Frame F;
    F.lds = (LAS unsigned char*)lds_raw; F.ldsx = F.lds + LDSX_OFF;
    volatile LAS unsigned* MISC = (volatile LAS unsigned*)(F.lds + MISC_OFF);
    F.wave = __builtin_amdgcn_readfirstlane((int)threadIdx.x >> 6); F.lane = 0; F.tid = 0;
    const int tid0 = (int)threadIdx.x;
    for (int u = tid0; u < (LDS_BYTES - MISC_OFF) / 4; u += NWAVES * 64) ((LAS unsigned*)(F.lds + MISC_OFF))[u] = 0u;
    __syncthreads();
    { volatile LAS unsigned long long* t64 = (volatile LAS unsigned long long*)(F.lds + MISC_OFF + 64);
      if (tid0 < 18) t64[tid0] = (unsigned long long)args.in[tid0]; else if (tid0 == 18) t64[18] = (unsigned long long)args.out; else if (tid0 == 19) t64[19] = (unsigned long long)args.ws; }
    __syncthreads();
    PT P{(volatile LAS unsigned*)(F.lds + MISC_OFF + 64)};
    unsigned* ctl = (unsigned*)(P.ws() + WS_CTL);
    XcdBarrier bar = xcd_barrier_post(ctl + CW_BAR + args.li * XCD_BAR_WORDS, MISC + 8);
#define IN(k) (opq(1) != 0)
#define SEAM(k) xcd_barrier(bar)

    if (IN(0)) REPS(1) { p0a_prologue(F, P); } SEAM(0);
    if (REP_SEL == 9) { for (int e = 0; e < 10; ++e) xcd_barrier(bar); }
    if (IN(1)) REPS(2) {
        { SchedW Sw{opq((int)blockIdx.x), (const char*)P.wsb(WS_WGT), (const char*)P.wsb(WS_WUB)}; EpiWeff E{P.wsb(WS_W1A), P.in(I_ASCALE), P.in(I_NORMG), P.wsf(WS_MOD)};
          pg8::gemm_phase<512, 512, 2048, EpiWeff, SchedW>(F.lds, F.ldsx, F.wave, Sw, E); }
        p0b_prologue(F, P);
    } SEAM(1);
#pragma unroll 1
    for (int l = 0; l < 2; ++l) {
        const int base = 2 + 3 * l;
        if (IN(base)) REPS(3) { SchedA Sa; Sa.init(opq((int)blockIdx.x), P.wsb(WS_XB), P.wsb(WS_W1A) + (size_t)l * 4 * 4096 * 1024);
            EpiPool E{P.wsb(WS_V), P.wsf(WS_TAIL), P.wsf(WS_HEADY), P.wsf(WS_HEADZ), P.wsf(WS_SSQ), P.wsf(WS_BZ) + (size_t)l * 4 * 2048};
            pg8::gemm_phase<1024, 1024, 1024, EpiPool, SchedA>(F.lds, F.ldsx, F.wave, Sa, E); } SEAM(base);
        if (IN(base + 1)) REPS(4) { pool_fixup(F, P); } SEAM(base + 1);
        if (IN(base + 2)) { StaticOrder So; So.init(T, 1024, GRID, opq((int)blockIdx.x), P.wsb(WS_V), P.wsb(WS_W2A) + (size_t)l * 1024 * 2048, 2048, 2048);
            EpiResid E{P.wsb(WS_XB), nullptr, P.wsf(WS_SSQ), P.wsf(WS_MOD) + (size_t)l * 4 * 3072 + 2048, l == 0 ? P.in(I_X) : nullptr};
            pg8::gemm_phase<2048, 2048, 2048, EpiResid, StaticOrder>(F.lds, F.ldsx, F.wave, So, E); } SEAM(base + 2);
    }
#pragma unroll 1
    for (int j = 0; j < 2; ++j) {
        const int base = 8 + 3 * j, l = 2 + j;
        if (IN(base)) REPS(7) { SchedB Sb; Sb.so.init(T, 2048, GRID, opq((int)blockIdx.x), P.wsb(WS_XB), P.wsb(WS_W1B) + (size_t)j * 4 * 2048 * 1024, 1024, 1024); Sb.with_kv = (j == 0); Sb.B2 = (const char*)P.wsb(WS_WKV);
            EpiQZKV E{P.wsb(WS_V), P.wsb(WS_V + 64 * MiB), P.wsb(WS_K), P.wsb(WS_VT), P.wsf(WS_SSQ), P.wsf(WS_BQZ) + (size_t)j * 4 * 2048, P.wsf(WS_BKV)};
            pg8::gemm_phase<1024, 1024, 1024, EpiQZKV, SchedB>(F.lds, F.ldsx, F.wave, Sb, E); } SEAM(base);
        if (IN(base + 1)) REPS(8) { att::attn_phase(F, P.wsb(WS_V), P.wsb(WS_V + 64 * MiB), P.wsb(WS_K), P.wsb(WS_VT), P.in(I_SINKS) + j * NH, P.in(I_RELB), P.wsb(WS_AO)); } SEAM(base + 1);
        if (IN(base + 2)) { StaticOrder So; So.init(T, 1024, GRID, opq((int)blockIdx.x), P.wsb(WS_AO), P.wsb(WS_W2B) + (size_t)j * 1024 * 1024, 1024, 1024);
            EpiResid E{P.wsb(WS_XB), j == 1 ? P.out() : nullptr, P.wsf(WS_SSQ), P.wsf(WS_MOD) + (size_t)l * 4 * 3072 + 2048, nullptr};
            pg8::gemm_phase<1024, 1024, 1024, EpiResid, StaticOrder>(F.lds, F.ldsx, F.wave, So, E); } SEAM(base + 2);
    }
    if (IN(14)) { final_norm(F, P.out(), P.wsf(WS_SSQ), P.in(I_FINALG)); }
#undef IN
#undef SEAM
}

extern "C" void kernel_launch(void* const* d_in, const int* in_sizes, int n_in, void* d_out, int out_size, void* d_ws, size_t ws_size, hipStream_t stream) {
    static int grid = 0;
    if (grid == 0) {
        if (n_in != 18 || out_size != T * D || ws_size < WS_END) { fprintf(stderr, "kernel_launch: unexpected shapes (n_in %d, out %d, ws %zu)\n", n_in, out_size, ws_size); grid = -1; return; }
        int dev = 0, cus = 0, per_cu = 0;
        hipGetDevice(&dev); hipDeviceGetAttribute(&cus, hipDeviceAttributeMultiprocessorCount, dev);
        if (hipFuncSetAttribute((const void*)mk_fwd, hipFuncAttributeMaxDynamicSharedMemorySize, LDS_BYTES) != hipSuccess) { fprintf(stderr, "kernel_launch: hipFuncSetAttribute failed\n"); grid = -1; return; }
        hipOccupancyMaxActiveBlocksPerMultiprocessor(&per_cu, (const void*)mk_fwd, NWAVES * 64, LDS_BYTES);
        (void)hipGetLastError();
        if (per_cu < 1) { fprintf(stderr, "kernel_launch: occupancy query says %d blocks per CU\n", per_cu); per_cu = 1; }
        grid = cus * 1;
        if (grid != 256) fprintf(stderr, "kernel_launch: %d CUs; the schedules assume 256\n", cus);
    }
    if (grid < 0) return;
    hipMemsetAsync((char*)d_ws + WS_CTL, 0, CTL_ZERO_BYTES, stream);
    Args a{};
    for (int i = 0; i < 18; ++i) a.in[i] = (const float*)d_in[i];
    a.out = (float*)d_out; a.ws = (unsigned char*)d_ws;
    unsigned char* ws = (unsigned char*)d_ws;
    const bf16* Q = (const bf16*)(ws + WS_V); const bf16* ZS = (const bf16*)(ws + WS_V + 64 * MiB);
    a.ph_lo = 0; a.ph_hi = 15; a.li = 0;
    hipLaunchKernelGGL(mk_fwd, dim3(grid), dim3(NWAVES * 64), LDS_BYTES, stream, a);
}
```
